# Optimizing an MI355X kernel written in HIP

```python
import jax, jax.numpy as jnp
from jax import lax
import numpy as np

D_MODEL = 4096
BATCH = 4
SEQ = 4096
DEPTH = 4

GRID_W = 64
HEAD_DIM = 128
ATTN_WIDTH = D_MODEL // 2
ATTN_HEADS = ATTN_WIDTH // HEAD_DIM
ATTN_KV_HEADS = ATTN_HEADS // 4
ATTN_GROUP = ATTN_HEADS // ATTN_KV_HEADS
KV_WIDTH = ATTN_KV_HEADS * HEAD_DIM
Q_BLOCK = 128
RET_WIDTH = D_MODEL - ATTN_WIDTH
RET_V_DIM = 256
RET_HEADS = RET_WIDTH // RET_V_DIM
RET_QK_DIM = 128
RET_QK_WIDTH = RET_HEADS * RET_QK_DIM
RET_CHUNK = 128
RET_DECAY_BASE_EXP = 5
MIX_WIDTH = ATTN_WIDTH + RET_WIDTH
ROPE_THETA = 10000.0
EPS = 1e-6

IN_SPLITS = (ATTN_WIDTH, KV_WIDTH, KV_WIDTH, ATTN_WIDTH, RET_QK_WIDTH, RET_QK_WIDTH, RET_WIDTH, RET_WIDTH)
IN_WIDTH = sum(IN_SPLITS)
SPLIT_POINTS = tuple(int(p) for p in np.cumsum(IN_SPLITS)[:-1])

kernel_name = 'hymba_gqa_axialrope_biretention_encoder'


def rmsnorm(x, g):
    xf = x.astype(jnp.float32)
    y = xf * lax.rsqrt(jnp.mean(xf * xf, axis=-1, keepdims=True) + EPS)
    return (y * g.astype(jnp.float32)).astype(x.dtype)


def axial_rope_tables(seq_len):
    rows = seq_len // GRID_W
    row = jnp.repeat(jnp.arange(rows), GRID_W).astype(jnp.float32)
    col = jnp.tile(jnp.arange(GRID_W), rows).astype(jnp.float32)
    axis_dim = HEAD_DIM // 2
    inv = ROPE_THETA ** (-jnp.arange(0, axis_dim, 2, dtype=jnp.float32) / axis_dim)
    ang_r = row[:, None] * inv[None, :]
    ang_c = col[:, None] * inv[None, :]
    return (jnp.cos(ang_r), jnp.sin(ang_r), jnp.cos(ang_c), jnp.sin(ang_c))


def _rotate(xp, cos, sin):
    x1, x2 = jnp.split(xp, 2, axis=-1)
    c = cos[None, :, None, :]
    s = sin[None, :, None, :]
    return jnp.concatenate([x1 * c - x2 * s, x1 * s + x2 * c], axis=-1)


def apply_axial_rope(x, rope):
    cos_r, sin_r, cos_c, sin_c = rope
    xf = x.astype(jnp.float32)
    half = x.shape[-1] // 2
    out = jnp.concatenate([_rotate(xf[..., :half], cos_r, sin_r),
                           _rotate(xf[..., half:], cos_c, sin_c)], axis=-1)
    return out.astype(x.dtype)


def gqa_attention(q, k, v):
    B, S = q.shape[0], q.shape[1]
    nb = S // Q_BLOCK
    qb = q.reshape(B, nb, Q_BLOCK, ATTN_KV_HEADS, ATTN_GROUP, HEAD_DIM).transpose(1, 0, 3, 4, 2, 5)
    kt = k.transpose(0, 2, 1, 3)
    vt = v.transpose(0, 2, 1, 3)

    def block(qblk):
        s = jnp.einsum('bkgqd,bksd->bkgqs', qblk, kt).astype(jnp.float32)
        p = jax.nn.softmax(s, axis=-1).astype(vt.dtype)
        return jnp.einsum('bkgqs,bksd->bkgqd', p, vt)

    o = lax.map(block, qb)
    return o.transpose(1, 0, 4, 2, 3, 5).reshape(B, S, ATTN_WIDTH)


def retention_chunkwise(q, k, v, log_g, include_diag):
    q = q.astype(jnp.float32)
    k = k.astype(jnp.float32)
    v = v.astype(jnp.float32)
    log_g = log_g.astype(jnp.float32)
    B, H, S, dk = q.shape
    dv = v.shape[-1]
    C = RET_CHUNK
    n = S // C
    qc = q.reshape(B, H, n, C, dk).transpose(2, 0, 1, 3, 4)
    kc = k.reshape(B, H, n, C, dk).transpose(2, 0, 1, 3, 4)
    vc = v.reshape(B, H, n, C, dv).transpose(2, 0, 1, 3, 4)
    idx = jnp.arange(C, dtype=jnp.float32)
    diff = idx[:, None] - idx[None, :]
    mask = (diff >= 0) if include_diag else (diff > 0)
    safe = jnp.where(mask, diff, 0.0)
    decay_in = jnp.where(mask[None], jnp.exp(log_g[:, None, None] * safe[None]), 0.0)
    xi = jnp.exp(log_g[:, None] * (idx + 1.0)[None])[..., None]
    zeta = jnp.exp(log_g[:, None] * (C - 1.0 - idx)[None])[..., None]
    g_chunk = jnp.exp(log_g * C)[:, None, None]

    def step(state, inp):
        qj, kj, vj = inp
        scores = jnp.einsum('bhqd,bhkd->bhqk', qj, kj) * decay_in
        inner = jnp.einsum('bhqk,bhke->bhqe', scores, vj)
        cross = jnp.einsum('bhqd,bhde->bhqe', qj * xi, state)
        state = g_chunk * state + jnp.einsum('bhkd,bhke->bhde', kj * zeta, vj)
        return state, inner + cross

    state0 = jnp.zeros((B, H, dk, dv), jnp.float32)
    _, out = lax.scan(step, state0, (qc, kc, vc))
    return out.transpose(1, 2, 0, 3, 4).reshape(B, H, S, dv)


def bidirectional_retention(q, k, v, log_gf, log_gb):
    fwd = retention_chunkwise(q, k, v, log_gf, True)
    bwd = retention_chunkwise(jnp.flip(q, 2), jnp.flip(k, 2), jnp.flip(v, 2), log_gb, False)
    return fwd + jnp.flip(bwd, 2)


def setup_inputs(seed: int = 0) -> dict:
    key = jax.random.key(seed)
    ks = jax.random.split(key, 12)
    x = jax.random.normal(ks[0], (BATCH, SEQ, D_MODEL), jnp.float32)
    norm_w = 1.0 + 0.02 * jax.random.normal(ks[1], (DEPTH, D_MODEL), jnp.float32)
    w_in = jax.random.normal(ks[2], (DEPTH, D_MODEL, IN_WIDTH), jnp.float32) * (D_MODEL ** -0.5)
    q_norm = 1.0 + 0.02 * jax.random.normal(ks[3], (DEPTH, HEAD_DIM), jnp.float32)
    k_norm = 1.0 + 0.02 * jax.random.normal(ks[4], (DEPTH, HEAD_DIM), jnp.float32)
    base = jnp.asarray(np.log(2.0 ** (RET_DECAY_BASE_EXP + np.arange(RET_HEADS)) - 1.0), jnp.float32)
    ret_decay_fwd = base[None] + 0.1 * jax.random.normal(ks[5], (DEPTH, RET_HEADS), jnp.float32)
    ret_decay_bwd = base[None] + 0.1 * jax.random.normal(ks[6], (DEPTH, RET_HEADS), jnp.float32)
    ret_norm = 1.0 + 0.02 * jax.random.normal(ks[7], (DEPTH, RET_HEADS, RET_V_DIM), jnp.float32)
    w_out = jax.random.normal(ks[8], (DEPTH, MIX_WIDTH, D_MODEL), jnp.float32) * (MIX_WIDTH ** -0.5)
    final_norm = 1.0 + 0.02 * jax.random.normal(ks[9], (D_MODEL,), jnp.float32)
    return {'x': x, 'norm_w': norm_w, 'w_in': w_in, 'q_norm': q_norm, 'k_norm': k_norm,
            'ret_decay_fwd': ret_decay_fwd, 'ret_decay_bwd': ret_decay_bwd, 'ret_norm': ret_norm,
            'w_out': w_out, 'final_norm': final_norm}


def reference(x, norm_w, w_in, q_norm, k_norm, ret_decay_fwd, ret_decay_bwd, ret_norm, w_out, final_norm):
    B, S, _ = x.shape
    rope = axial_rope_tables(S)
    attn_scale = HEAD_DIM ** -0.5
    ret_scale = RET_QK_DIM ** -0.5
    for l in range(DEPTH):
        h = rmsnorm(x, norm_w[l])
        proj = h @ w_in[l]
        aq, ak, av, ag, rq, rk, rv, rg = jnp.split(proj, SPLIT_POINTS, axis=-1)

        aq = apply_axial_rope(rmsnorm(aq.reshape(B, S, ATTN_HEADS, HEAD_DIM), q_norm[l]), rope) * attn_scale
        ak = apply_axial_rope(rmsnorm(ak.reshape(B, S, ATTN_KV_HEADS, HEAD_DIM), k_norm[l]), rope)
        av = av.reshape(B, S, ATTN_KV_HEADS, HEAD_DIM)
        a_out = (jax.nn.silu(ag) * gqa_attention(aq, ak, av)).astype(x.dtype)

        rq = apply_axial_rope(rq.reshape(B, S, RET_HEADS, RET_QK_DIM), rope).transpose(0, 2, 1, 3)
        rk = (apply_axial_rope(rk.reshape(B, S, RET_HEADS, RET_QK_DIM), rope) * ret_scale).transpose(0, 2, 1, 3)
        rv = rv.reshape(B, S, RET_HEADS, RET_V_DIM).transpose(0, 2, 1, 3)
        log_gf = jax.nn.log_sigmoid(ret_decay_fwd[l].astype(jnp.float32))
        log_gb = jax.nn.log_sigmoid(ret_decay_bwd[l].astype(jnp.float32))
        r = bidirectional_retention(rq, rk, rv, log_gf, log_gb).transpose(0, 2, 1, 3)
        r = rmsnorm(r, ret_norm[l]).reshape(B, S, RET_WIDTH)
        r_out = (jax.nn.silu(rg.astype(jnp.float32)) * r).astype(x.dtype)

        x = x + jnp.concatenate([a_out, r_out], axis=-1) @ w_out[l]
    return rmsnorm(x, final_norm)
```

```cpp
#include <hip/hip_runtime.h>
#include <cstdio>
#include <cstdint>
namespace pg8 {
#define PG8_LAS __attribute__((address_space(3)))
typedef unsigned short bf16_t;
typedef short bf16x8 __attribute__((ext_vector_type(8)));
typedef float f32x4 __attribute__((ext_vector_type(4)));
typedef unsigned u32x4 __attribute__((ext_vector_type(4)));
constexpr int BM = 256, BK = 64, HALF = 128, HTB = HALF * BK * 2  , STAGE_BYTES = 8 * HTB, NXCD = 8, WGM = 8;

__host__ __device__ __forceinline__ int lds_byte(int r, int c) { const int st = (r >> 4) * 2 + (c >> 5), rr = r & 15, cc = c & 31, ob = rr * 64 + cc * 2; return st * 1024 + (ob ^ (((ob >> 9) & 1) << 5)); }
__host__ __device__ __forceinline__ void stage_rc(int b, int& R, int& C) { const int st = b / 1024, sb = b % 1024, swz = sb ^ (((sb >> 9) & 1) << 5); R = (st >> 1) * 16 + swz / 64; C = (st & 1) * 32 + (swz % 64) / 2; }
__host__ __device__ __forceinline__ int perm32(int rho) { const int n = rho >> 4, i = rho & 15; return 8 * (i >> 2) + 4 * n + (i & 3); }

struct Unit { int pm, pn; };
struct Gemm { const bf16_t* A; const bf16_t* Bt; int M, N, K; };

struct StaticOrder {
    int nM, nN, nwg, G, c;
    __host__ __device__ void init(int M, int N, int G_, int c_) { nM = M / BM; nN = N / BM; nwg = nM * nN; G = G_; c = c_; }
    __host__ __device__ bool next(int i, Unit& u) const {
        const long L = (long)i * G + c; if (L >= nwg) return false;
        int wgid = (int)L; { const int q = nwg / NXCD, r = nwg % NXCD, xcd = wgid % NXCD, off = wgid / NXCD; wgid = (xcd < r ? xcd * (q + 1) : r * (q + 1) + (xcd - r) * q) + off; }
        const int nig = WGM * nN, gid = wgid / nig, fm = gid * WGM, gsz = (nM - fm) < WGM ? (nM - fm) : WGM;
        u.pm = fm + ((wgid % nig) % gsz); u.pn = (wgid % nig) / gsz; return true;
    }
    __device__ __forceinline__ void a_ready(const Unit&) const {}
    __device__ __forceinline__ void done(const Unit&) const {}
};

__device__ __forceinline__ unsigned cvt_pk_bf16(float lo, float hi) { unsigned r; asm volatile("v_cvt_pk_bf16_f32 %0, %1, %2" : "=v"(r) : "v"(lo), "v"(hi)); return r; }
typedef float f32x2 __attribute__((ext_vector_type(2)));
__device__ __forceinline__ f32x2 gelu_pk(f32x2 v) {
    const f32x2 av = __builtin_elementwise_abs(v), d = av * 0.2316418882f + 1.0f;
    f32x2 t; t.x = __builtin_amdgcn_rcpf(d.x); t.y = __builtin_amdgcn_rcpf(d.y);
    f32x2 q = t * 0.5307027145f + (-0.7265760135f); q = q * t + 0.7107068705f; q = q * t + (-0.142248368f); q = q * t + 0.127414796f; q = q * t;
    const f32x2 s = (v * v) * (-0.72134752044f);
    f32x2 e; e.x = __builtin_amdgcn_exp2f(s.x); e.y = __builtin_amdgcn_exp2f(s.y);
    const f32x2 m = v * (q * e), r = v - m;
    f32x2 o; o.x = v.x < 0.f ? m.x : r.x; o.y = v.y < 0.f ? m.y : r.y; return o;
}

template <int ACT  > struct EpiBf16 {
    static constexpr bool PERM = true, AFTER_DRAIN = false; static_assert(ACT == 0 || ACT == 1, "EpiBf16: ACT is 0 (none) or 1 (gelu_pk)");
    bf16_t* O; int ldc; const float* bias; int split_cols; size_t split_stride; float scale0;
    __device__ __forceinline__ void operator()(const f32x4 (&acc)[2][2][4][2], const Unit& u, int wr, int wc, int fr, int fq) const {
        const int row0 = u.pm * BM + wr * 64 + fr; int colt = u.pn * BM; bf16_t* base = O;
        float sc = 1.f; if (split_cols) { const int t = colt / split_cols; base += (size_t)t * split_stride; colt -= t * split_cols; if (t == 0) sc = scale0; }
        const int col0 = colt + wc * 32 + 8 * fq, bcol0 = u.pn * BM + wc * 32 + 8 * fq;
        f32x4 bv[2][2];
#pragma unroll
        for (int bj = 0; bj < 2; ++bj)
#pragma unroll
            for (int n = 0; n < 2; ++n) bv[bj][n] = bias ? *(const f32x4*)(bias + bcol0 + bj * HALF + 4 * n) : (f32x4){0.f, 0.f, 0.f, 0.f};
#pragma unroll
        for (int ai = 0; ai < 2; ++ai)
#pragma unroll
            for (int m = 0; m < 4; ++m) { bf16_t* rowp = base + (size_t)(row0 + ai * HALF + m * 16) * ldc + col0;
#pragma unroll
                for (int bj = 0; bj < 2; ++bj) { f32x4 v0 = acc[ai][bj][m][0] + bv[bj][0], v1 = acc[ai][bj][m][1] + bv[bj][1];
                    if (ACT == 1) { f32x2 a = gelu_pk((f32x2){v0[0], v0[1]}), b = gelu_pk((f32x2){v0[2], v0[3]}), c = gelu_pk((f32x2){v1[0], v1[1]}), d = gelu_pk((f32x2){v1[2], v1[3]});
                        v0 = (f32x4){a.x, a.y, b.x, b.y}; v1 = (f32x4){c.x, c.y, d.x, d.y}; }
                    v0 = v0 * sc; v1 = v1 * sc; u32x4 w; w.x = cvt_pk_bf16(v0[0], v0[1]); w.y = cvt_pk_bf16(v0[2], v0[3]); w.z = cvt_pk_bf16(v1[0], v1[1]); w.w = cvt_pk_bf16(v1[2], v1[3]);
                    *(u32x4*)(rowp + bj * HALF) = w; } }
    }
};
template <class Epi, class Sched, bool ALIGN_EPI = false, bool SP2 = false>
__device__ __forceinline__ void gemm_phase(PG8_LAS unsigned char* lds, const Gemm g, const Sched& S, const Epi& E) {
    int tid_ = threadIdx.x; asm volatile("" : "+v"(tid_));
    const int tid = tid_, wid = __builtin_amdgcn_readfirstlane(tid >> 6), lane = tid & 63, wr = wid >> 2, wc = wid & 3, fr = lane & 15, fq = lane >> 4;
    const int K = g.K, nt = K / BK;
    unsigned voffA[2], voffB[2];
#pragma unroll
    for (int i = 0; i < 2; ++i) { int R, C; stage_rc(tid * 16 + i * 8192, R, C); const int Rb = Epi::PERM ? ((R & ~31) + perm32(R & 31)) : R;
        voffA[i] = (unsigned)(R * K + C) * 2u; voffB[i] = (unsigned)(Rb * K + C) * 2u; }
    const size_t kstep = (size_t)(BK * 2);
    const size_t hstep = (size_t)HALF * K * 2;
    const size_t tstep = 2 * hstep;
    const unsigned ldsw = (unsigned)wid * 1024u;
    const int aoff = lds_byte(wr * 64 + fr, fq * 8), boff = lds_byte(wc * 32 + fr, fq * 8);
#define PG8_SA(b, h) (((b) * 2 + (h)) * HTB)
#define PG8_SB(b, h) ((4 + (b) * 2 + (h)) * HTB)
#define PG8_STAGE(bufoff, gbase, voff) do { _Pragma("unroll") for (int _i = 0; _i < 2; ++_i) \
        __builtin_amdgcn_global_load_lds((const unsigned*)((const char*)(gbase) + (voff)[_i]), (PG8_LAS unsigned*)(lds + (bufoff) + ldsw + _i * 8192), 16, 0, 0); } while (0)
#define PG8_LDA(dst, b, h) do { _Pragma("unroll") for (int m = 0; m < 4; ++m) _Pragma("unroll") for (int k = 0; k < 2; ++k) dst[m][k] = *(const PG8_LAS bf16x8*)(lds + PG8_SA(b, h) + aoff + m * 2048 + k * 1024); } while (0)
#define PG8_LDB(dst, b, h) do { _Pragma("unroll") for (int n = 0; n < 2; ++n) _Pragma("unroll") for (int k = 0; k < 2; ++k) dst[n][k] = *(const PG8_LAS bf16x8*)(lds + PG8_SB(b, h) + boff + n * 2048 + k * 1024); } while (0)
#define PG8_MMA(ai, bj, At, Bt) do { __builtin_amdgcn_s_setprio(1); _Pragma("unroll") for (int m = 0; m < 4; ++m) _Pragma("unroll") for (int n = 0; n < 2; ++n) _Pragma("unroll") for (int k = 0; k < 2; ++k) \
        acc[ai][bj][m][n] = __builtin_amdgcn_mfma_f32_16x16x32_bf16(Bt[n][k], At[m][k], acc[ai][bj][m][n], 0, 0, 0); __builtin_amdgcn_s_setprio(0); } while (0)
#define PG8_WAIT_V(n) asm volatile("s_waitcnt vmcnt(" #n ")" ::: "memory")
#define PG8_WAIT_L(n) asm volatile("s_waitcnt lgkmcnt(" #n ")" ::: "memory")
#define PG8_BAR __builtin_amdgcn_s_barrier()
#define PG8_SCHED __builtin_amdgcn_sched_barrier(0)
    Unit cur, nxt; int ui = 0;
    if (!S.next(0, cur)) return;
    f32x4 acc[2][2][4][2];
#pragma unroll
    for (int a = 0; a < 2; ++a)
#pragma unroll
        for (int b = 0; b < 2; ++b)
#pragma unroll
            for (int m = 0; m < 4; ++m)
#pragma unroll
                for (int n = 0; n < 2; ++n) acc[a][b][m][n] = (f32x4){0.f, 0.f, 0.f, 0.f};
    bf16x8 At[4][2], B0[2][2], B1[2][2];
    const char* cA = (const char*)g.A + (size_t)cur.pm * tstep; const char* cB = (const char*)g.Bt + (size_t)cur.pn * tstep;
    S.a_ready(cur);
    if constexpr (SP2) {
        PG8_STAGE(PG8_SB(0, 0), cB, voffB); PG8_STAGE(PG8_SB(0, 1), cB + hstep, voffB); PG8_STAGE(PG8_SA(0, 0), cA, voffA); PG8_STAGE(PG8_SA(0, 1), cA + hstep, voffA);
        if (wr == 1) PG8_BAR;
        PG8_WAIT_V(2); PG8_BAR;
        PG8_STAGE(PG8_SB(1, 0), cB + kstep, voffB); PG8_STAGE(PG8_SA(1, 0), cA + kstep, voffA); PG8_STAGE(PG8_SB(1, 1), cB + hstep + kstep, voffB);
        PG8_WAIT_V(6); PG8_BAR;
    } else {
        PG8_STAGE(PG8_SB(0, 0), cB, voffB); PG8_STAGE(PG8_SA(0, 0), cA, voffA); PG8_STAGE(PG8_SB(0, 1), cB + hstep, voffB); PG8_STAGE(PG8_SA(0, 1), cA + hstep, voffA);
        if (wr == 1) PG8_BAR;
        PG8_WAIT_V(4); PG8_BAR;
        PG8_STAGE(PG8_SB(1, 0), cB + kstep, voffB); PG8_STAGE(PG8_SA(1, 0), cA + kstep, voffA); PG8_STAGE(PG8_SB(1, 1), cB + hstep + kstep, voffB);
        PG8_WAIT_V(6); PG8_BAR;
    }
    for (;;) {
        const bool has_next = S.next(ui + 1, nxt);
        const char* nA = has_next ? (const char*)g.A + (size_t)nxt.pm * tstep : cA; const char* nB = has_next ? (const char*)g.Bt + (size_t)nxt.pn * tstep : cB;
        for (int t = 0; t < nt; t += 2) {
            const bool last = (t == nt - 2);
            const char* a1 = cA + (size_t)(t + 1) * kstep;
            const char* a2 = last ? nA : cA + (size_t)(t + 2) * kstep; const char* b2 = last ? nB : cB + (size_t)(t + 2) * kstep;
            const char* a3 = a2 + kstep; const char* b3 = b2 + kstep;
            if (last && has_next) S.a_ready(nxt);
            if constexpr (SP2) {
            PG8_LDB(B0, 0, 0); PG8_LDB(B1, 0, 1); PG8_SCHED; PG8_LDA(At, 0, 0); PG8_STAGE(PG8_SA(1, 1), a1 + hstep, voffA);
            PG8_WAIT_V(8); PG8_WAIT_L(0); PG8_BAR; PG8_MMA(0, 0, At, B0); PG8_MMA(0, 1, At, B1); PG8_BAR; PG8_SCHED;
            PG8_LDA(At, 0, 1); PG8_STAGE(PG8_SB(0, 0), b2, voffB); PG8_STAGE(PG8_SB(0, 1), b2 + hstep, voffB); PG8_STAGE(PG8_SA(0, 0), a2, voffA);
            PG8_WAIT_V(8); PG8_WAIT_L(0); PG8_BAR; PG8_MMA(1, 0, At, B0); PG8_MMA(1, 1, At, B1); PG8_BAR; PG8_SCHED;
            PG8_LDB(B0, 1, 0); PG8_LDB(B1, 1, 1); PG8_SCHED; PG8_LDA(At, 1, 0); PG8_STAGE(PG8_SA(0, 1), a2 + hstep, voffA);
            PG8_WAIT_V(8); PG8_WAIT_L(0); PG8_BAR; PG8_MMA(0, 0, At, B0); PG8_MMA(0, 1, At, B1); PG8_BAR; PG8_SCHED;
            PG8_LDA(At, 1, 1); PG8_STAGE(PG8_SB(1, 0), b3, voffB); PG8_STAGE(PG8_SB(1, 1), b3 + hstep, voffB); PG8_STAGE(PG8_SA(1, 0), a3, voffA);
            PG8_WAIT_V(8); PG8_WAIT_L(0); PG8_BAR; PG8_MMA(1, 0, At, B0); PG8_MMA(1, 1, At, B1); PG8_BAR; PG8_SCHED;
            } else {
            PG8_LDB(B0, 0, 0); PG8_SCHED; PG8_LDA(At, 0, 0); PG8_STAGE(PG8_SA(1, 1), a1 + hstep, voffA);
            PG8_WAIT_L(8); PG8_BAR; PG8_WAIT_L(0); PG8_MMA(0, 0, At, B0); PG8_BAR; PG8_SCHED;
            PG8_LDB(B1, 0, 1); PG8_STAGE(PG8_SB(0, 0), b2, voffB);
            PG8_BAR; PG8_WAIT_L(0); PG8_MMA(0, 1, At, B1); PG8_BAR;
            PG8_LDA(At, 0, 1); PG8_STAGE(PG8_SA(0, 0), a2, voffA);
            PG8_BAR; PG8_WAIT_L(0); PG8_MMA(1, 0, At, B0); PG8_BAR; PG8_SCHED;
            PG8_STAGE(PG8_SB(0, 1), b2 + hstep, voffB);
            PG8_WAIT_V(6); PG8_BAR; PG8_MMA(1, 1, At, B1); PG8_BAR;
            PG8_LDB(B0, 1, 0); PG8_SCHED; PG8_LDA(At, 1, 0); PG8_STAGE(PG8_SA(0, 1), a2 + hstep, voffA);
            PG8_WAIT_L(8); PG8_BAR; PG8_WAIT_L(0); PG8_MMA(0, 0, At, B0); PG8_BAR; PG8_SCHED;
            PG8_LDB(B1, 1, 1); PG8_STAGE(PG8_SB(1, 0), b3, voffB);
            PG8_BAR; PG8_WAIT_L(0); PG8_MMA(0, 1, At, B1); PG8_BAR;
            PG8_LDA(At, 1, 1); PG8_STAGE(PG8_SA(1, 0), a3, voffA);
            PG8_BAR; PG8_WAIT_L(0); PG8_MMA(1, 0, At, B0); PG8_BAR; PG8_SCHED;
            PG8_STAGE(PG8_SB(1, 1), b3 + hstep, voffB);
            PG8_WAIT_V(6); PG8_BAR; PG8_MMA(1, 1, At, B1); PG8_BAR;
            }
        }
        if constexpr (ALIGN_EPI) { if (wr == 0) PG8_BAR; }
        if constexpr (!Epi::AFTER_DRAIN) { E(acc, cur, wr, wc, fr, fq); S.done(cur); }
        if (!has_next) break;
#pragma unroll
        for (int a = 0; a < 2; ++a)
#pragma unroll
            for (int b = 0; b < 2; ++b)
#pragma unroll
                for (int m = 0; m < 4; ++m)
#pragma unroll
                    for (int n = 0; n < 2; ++n) acc[a][b][m][n] = (f32x4){0.f, 0.f, 0.f, 0.f};
        cur = nxt; cA = nA; cB = nB; ++ui;
        if constexpr (ALIGN_EPI) { if (wr == 1) PG8_BAR; }
    }
    PG8_WAIT_V(0);
    if constexpr (!ALIGN_EPI) { if (wr == 0) PG8_BAR; }
    PG8_BAR;
    if constexpr (Epi::AFTER_DRAIN) { E.fused(acc, cur, wr, wc, fr, fq, lds, wid, lane); S.done(cur); }
#undef PG8_SA
#undef PG8_SB
#undef PG8_STAGE
#undef PG8_LDA
#undef PG8_LDB
#undef PG8_MMA
#undef PG8_WAIT_V
#undef PG8_WAIT_L
#undef PG8_BAR
#undef PG8_SCHED
}
}
namespace pg8 {
struct EpiResF32 {
    static constexpr bool PERM = false, AFTER_DRAIN = false;
    const float* base; float* out; int ldc;
    __device__ __forceinline__ void operator()(const f32x4 (&acc)[2][2][4][2], const Unit& u, int wr, int wc, int fr, int fq) const {
        const int row0 = u.pm * BM + wr * 64 + fr, col0 = u.pn * BM + wc * 32 + 4 * fq;
#pragma unroll
        for (int ai = 0; ai < 2; ++ai)
#pragma unroll
            for (int m = 0; m < 4; ++m) { const size_t off = (size_t)(row0 + ai * HALF + m * 16) * ldc + col0;
#pragma unroll
                for (int bj = 0; bj < 2; ++bj)
#pragma unroll
                    for (int n = 0; n < 2; ++n) { const f32x4 bs = *(const f32x4*)(base + off + bj * HALF + n * 16); *(f32x4*)(out + off + bj * HALF + n * 16) = bs + acc[ai][bj][m][n]; }
                asm volatile("" ::: "memory"); }
    }
};
}
#define GAS __attribute__((address_space(1)))
#define LAS __attribute__((address_space(3)))
typedef unsigned short bf16;
typedef unsigned v4u __attribute__((ext_vector_type(4)));
typedef float f32x4 __attribute__((ext_vector_type(4)));
typedef short bf16x8 __attribute__((ext_vector_type(8)));
typedef GAS unsigned gu32;
typedef GAS unsigned long long gu64;
#define RLX_AGENT __ATOMIC_RELAXED, __HIP_MEMORY_SCOPE_AGENT
#define LDS_WAIT() asm volatile("s_waitcnt lgkmcnt(0)" ::: "memory")
#define VM_WAIT() asm volatile("s_waitcnt vmcnt(0)" ::: "memory")
__device__ __forceinline__ unsigned long long rt() { return __builtin_amdgcn_s_memrealtime(); }
__device__ __forceinline__ unsigned f2bf(float f) { unsigned u = __builtin_bit_cast(unsigned, f); return (u + 0x7fffu + ((u >> 16) & 1u)) >> 16; }
__device__ __forceinline__ unsigned pk2(float lo, float hi) { return f2bf(lo) | (f2bf(hi) << 16); }

#define XB_TMO      128
#define XB_XCNT(j)  (256  + 64 * (j))
#define XB_XSUB(j)  (1280 + 64 * (j))
#define XB_XGEN(j)  (2304 + 64 * (j))
#define XB_TOP      3328
#define XB_TOPGEN   3392
#define XCD_BAR_WORDS 3456
#define XB_SPIN_CAP (1u << 18)

__device__ __forceinline__ unsigned xb_ld(unsigned* p)              { return __hip_atomic_load(p, __ATOMIC_RELAXED, __HIP_MEMORY_SCOPE_AGENT); }
__device__ __forceinline__ unsigned xb_add(unsigned* p, unsigned v) { return __hip_atomic_fetch_add(p, v, __ATOMIC_RELAXED, __HIP_MEMORY_SCOPE_AGENT); }
__device__ __forceinline__ unsigned xb_xcc_id() { return (unsigned)__builtin_amdgcn_s_getreg((3 << 11) | 20) & 0xFu; }
#define XB_SPIN(cond, bar) do { unsigned _sp = 0; while (cond) { __builtin_amdgcn_s_sleep(1); \
    if ((++_sp & 255u) == 0u) { if (xb_ld(&(bar)[XB_TMO])) break; if (_sp > XB_SPIN_CAP) { atomicAdd(&(bar)[XB_TMO], 1u); break; } } } } while (0)

struct XcdBarrier {
    unsigned* bar; unsigned x;
    volatile LAS unsigned* st;
};

__device__ __forceinline__ XcdBarrier xcd_barrier_post(unsigned* bar, volatile LAS unsigned* st) {
    XcdBarrier b; b.bar = bar; b.x = xb_xcc_id(); b.st = st;
    if (threadIdx.x == 0) (void)xb_add(&bar[XB_XCNT(b.x)], 1u);
    return b;
}
__device__ __forceinline__ void xcd_barrier_complete(unsigned* bar, unsigned x, unsigned& nloc, unsigned& nx) {
    const unsigned G = gridDim.x * gridDim.y * gridDim.z;
    unsigned sum, cnt, mine, sp = 0u;
    for (;;) {
        sum = 0u; cnt = 0u; mine = 0u;
#pragma unroll
        for (unsigned j = 0; j < 16; ++j) { const unsigned c = xb_ld(&bar[XB_XCNT(j)]); sum += c; cnt += (c > 0u) ? 1u : 0u; mine = (j == x) ? c : mine; }
        if (sum == G) break;
        __builtin_amdgcn_s_sleep(1);
        if ((++sp & 255u) == 0u) { if (xb_ld(&bar[XB_TMO])) break; if (sp > XB_SPIN_CAP) { atomicAdd(&bar[XB_TMO], 1u); break; } }
    }
    nloc = mine > 0u ? mine : 1u; nx = cnt > 0u ? cnt : 1u;
}

__device__ __forceinline__ void xcd_barrier(const XcdBarrier& b) {
    asm volatile("s_waitcnt vmcnt(0)" ::: "memory");
    __syncthreads();
    if (threadIdx.x == 0) {
        unsigned* bar = b.bar;
        __builtin_amdgcn_s_waitcnt(0);
        unsigned nloc = b.st[0], nx = b.st[1];
        if (nloc == 0u) { xcd_barrier_complete(bar, b.x, nloc, nx); b.st[0] = nloc; b.st[1] = nx; }
        const unsigned old = xb_add(&bar[XB_XSUB(b.x)], 1u);
        const unsigned gen = old / nloc;
        if (old + 1u == (gen + 1u) * nloc) {
            __builtin_amdgcn_fence(__ATOMIC_RELEASE, "agent");
            asm volatile("s_waitcnt vmcnt(0)" ::: "memory");
            const unsigned og = xb_add(&bar[XB_TOP], 1u);
            const unsigned tg = og / nx;
            if (og + 1u == (tg + 1u) * nx) xb_add(&bar[XB_TOPGEN], 1u);
            else XB_SPIN(xb_ld(&bar[XB_TOPGEN]) == tg, bar);
            __builtin_amdgcn_fence(__ATOMIC_ACQUIRE, "agent");
            xb_add(&bar[XB_XGEN(b.x)], 1u);
            asm volatile("s_waitcnt vmcnt(0)" ::: "memory");
        } else {
            XB_SPIN(xb_ld(&bar[XB_XGEN(b.x)]) == gen, bar);
            __builtin_amdgcn_fence(__ATOMIC_ACQUIRE, "agent");
            asm volatile("s_waitcnt vmcnt(0)" ::: "memory");
        }
    }
    __syncthreads();
}

constexpr int BATCH = 4, SEQ = 4096, DM = 4096, DEPTH = 4, M = BATCH * SEQ;
constexpr int NIN = 11264, LDP = NIN;
constexpr int C_AQ = 0, C_AK = 2048, C_AV = 2560, C_AG = 3072, C_RQ = 5120, C_RK = 6144, C_RV = 7168, C_RG = 9216;
constexpr int NHQ = 16, NHKV = 4, RH = 8, NCH = SEQ / 128;
constexpr float EPS = 1e-6f;
constexpr int NWAVES = 8;
#ifndef MK_PER_PHASE
#define MK_PER_PHASE 0
#endif
constexpr int NPH = 2 + 6 * DEPTH;
#ifndef PH_MASK
#define PH_MASK 0x3ff
#endif
#define PH_EN(k) ((PH_MASK >> (k)) & 1)

constexpr size_t MiB = 1u << 20;
constexpr size_t WS_CTL = 0, CTL_ZERO_BYTES = 1 * MiB;
constexpr size_t WS_ROPE = 1 * MiB;
constexpr size_t WS_WIN = 2 * MiB;
constexpr size_t WS_WOUT = WS_WIN + (size_t)DEPTH * NIN * DM * 2;
constexpr size_t WS_XCUR = WS_WOUT + (size_t)DEPTH * DM * DM * 2;
constexpr size_t WS_XN = WS_XCUR + (size_t)M * DM * 4;
constexpr size_t WS_PROJ = WS_XN + (size_t)M * DM * 2;
constexpr size_t WS_MIX = WS_PROJ + (size_t)M * NIN * 2;
constexpr size_t WS_FST = WS_MIX + (size_t)M * DM * 2;
constexpr size_t WS_END = WS_FST + (size_t)2 * BATCH * RH * NCH * 128 * 256 * 2;
constexpr int CW_BAR = 4096;

constexpr int RING_BYTES = 131072;
constexpr int LDSCTL_OFF = RING_BYTES, MISC_OFF = LDSCTL_OFF + 320;
constexpr int LDS_BYTES = 147456;

typedef short s16x4 __attribute__((ext_vector_type(4)));
typedef float f32x16 __attribute__((ext_vector_type(16)));
typedef unsigned u32x4 __attribute__((ext_vector_type(4)));
#define SBAR() __builtin_amdgcn_sched_barrier(0)

__device__ __forceinline__ float bf2f(unsigned short x) { return __uint_as_float((unsigned)x << 16); }
typedef float f32x2_t __attribute__((ext_vector_type(2))); typedef __bf16 bf16x2_t __attribute__((ext_vector_type(2)));
__device__ __forceinline__ unsigned cvtpk(float lo, float hi) { f32x2_t v = {lo, hi}; bf16x2_t r = __builtin_convertvector(v, bf16x2_t); return __builtin_bit_cast(unsigned, r); }
__device__ __forceinline__ unsigned short f2bf1(float x) { return (unsigned short)(cvtpk(x, x) & 0xffffu); }
__device__ __forceinline__ bf16x8 ld8(const bf16* p) { return *reinterpret_cast<const bf16x8*>(p); }
__device__ __forceinline__ void unpack8(bf16x8 v, float* f) {
    const u32x4 w = __builtin_bit_cast(u32x4, v);
#pragma unroll
    for (int i = 0; i < 4; ++i) { f[2 * i] = __uint_as_float(w[i] << 16); f[2 * i + 1] = __uint_as_float(w[i] & 0xffff0000u); }
}
__device__ __forceinline__ bf16x8 pack8(const float* f) {
    u32x4 w; w.x = cvtpk(f[0], f[1]); w.y = cvtpk(f[2], f[3]); w.z = cvtpk(f[4], f[5]); w.w = cvtpk(f[6], f[7]); return __builtin_bit_cast(bf16x8, w);
}
__device__ __forceinline__ bf16x8 scale8(bf16x8 v, float s) { float f[8]; unpack8(v, f);
#pragma unroll
    for (int i = 0; i < 8; ++i) f[i] *= s;
    return pack8(f); }
__device__ __forceinline__ float silu_f(float x) { return x * __builtin_amdgcn_rcpf(1.0f + __builtin_amdgcn_exp2f(-1.4426950408889634f * x)); }
__device__ __forceinline__ float wave_sum(float v) {
#pragma unroll
    for (int o = 1; o < 64; o <<= 1) v += __shfl_xor(v, o);
    return v;
}
__device__ __forceinline__ float log2_sigmoid(float x) {
    const float y = expf(-x); float l;
    if (y < 0.25f) { const float y2 = y * y; l = y * (1.f + y * (-0.5f + y * (1.f / 3.f + y * (-0.25f + y * (0.2f + y * (-1.f / 6.f + y * (1.f / 7.f + y * (-0.125f + y * (1.f / 9.f))))))))); (void)y2; }
    else l = logf(1.f + y);
    return -l * 1.4426950408889634f;
}

#define KSWZ(row, colB) ((row) * 256 + ((colB) ^ (((row) & 7) << 4)))
__device__ __forceinline__ int crow(int r, int hi) { return (r & 3) + 8 * (r >> 2) + 4 * hi; }
constexpr float ATT_SCALE = 0.088388347648318440f;
constexpr float ATT_THR = 8.f;
__device__ __forceinline__ void partialSM(f32x16& p0, f32x16& p1, float& m_reg, float& mn, float& alpha) {
  constexpr float C = ATT_SCALE * 1.4426950408889634f;
  float pmax = p0[0];
#pragma unroll
  for (int r = 1; r < 16; ++r) pmax = fmaxf(pmax, p0[r]);
#pragma unroll
  for (int r = 0; r < 16; ++r) pmax = fmaxf(pmax, p1[r]);
  { auto rr = __builtin_amdgcn_permlane32_swap(__float_as_uint(pmax), __float_as_uint(pmax), false, false);
    pmax = fmaxf(__uint_as_float(rr[0]), __uint_as_float(rr[1])); }
  if (__builtin_expect(__all(pmax - m_reg <= ATT_THR / ATT_SCALE), 1)) { mn = m_reg; alpha = 1.f; }
  else { mn = fmaxf(m_reg, pmax); alpha = __builtin_amdgcn_exp2f((m_reg - mn) * C); m_reg = mn; }
  float mnC = -mn * C;
#pragma unroll
  for (int r = 0; r < 16; ++r) p0[r] = fmaf(p0[r], C, mnC);
#pragma unroll
  for (int r = 0; r < 16; ++r) p1[r] = fmaf(p1[r], C, mnC);
#pragma unroll
  for (int r = 0; r < 16; ++r) p0[r] = __builtin_amdgcn_exp2f(p0[r]);
}
#define PK4(P, BASE, OUT) do { unsigned a0 = cvtpk(P[BASE + 0], P[BASE + 1]), a1 = cvtpk(P[BASE + 2], P[BASE + 3]);   \
    unsigned b0 = cvtpk(P[BASE + 4], P[BASE + 5]), b1 = cvtpk(P[BASE + 6], P[BASE + 7]);                              \
    auto r0 = __builtin_amdgcn_permlane32_swap(a0, b0, false, false); auto r1 = __builtin_amdgcn_permlane32_swap(a1, b1, false, false); \
    u32x4 w = {r0[0], r1[0], r0[1], r1[1]}; OUT = *reinterpret_cast<bf16x8*>(&w); } while (0)
__device__ __forceinline__ void finishSM(f32x16& p0, f32x16& p1, float alpha, float& l_reg, bf16x8& pa0, bf16x8& pa1, bf16x8& pa2, bf16x8& pa3) {
#pragma unroll
  for (int r = 0; r < 16; ++r) p1[r] = __builtin_amdgcn_exp2f(p1[r]);
  float ps = 0;
#pragma unroll
  for (int r = 0; r < 16; ++r) ps += p0[r];
#pragma unroll
  for (int r = 0; r < 16; ++r) ps += p1[r];
  { auto rr = __builtin_amdgcn_permlane32_swap(__float_as_uint(ps), __float_as_uint(ps), false, false);
    ps = __uint_as_float(rr[0]) + __uint_as_float(rr[1]); }
  l_reg = l_reg * alpha + ps;
  PK4(p0, 0, pa0); PK4(p0, 8, pa1); PK4(p1, 0, pa2); PK4(p1, 8, pa3);
}
__device__ __forceinline__ void qkt(f32x16& p0, f32x16& p1, const char* Ks, const bf16x8* qr, int r32, int hi) {
  p0 = f32x16{}; p1 = f32x16{};
#pragma unroll
  for (int d0 = 0; d0 < 8; ++d0) { int cb = (d0 * 16 + hi * 8) * 2;
    bf16x8 b0 = *reinterpret_cast<const bf16x8*>(Ks + KSWZ(r32, cb));
    bf16x8 b1 = *reinterpret_cast<const bf16x8*>(Ks + KSWZ(32 + r32, cb));
    p0 = __builtin_amdgcn_mfma_f32_32x32x16_bf16(b0, qr[d0], p0, 0, 0, 0);
    p1 = __builtin_amdgcn_mfma_f32_32x32x16_bf16(b1, qr[d0], p1, 0, 0, 0); }
}
__device__ __forceinline__ int v_st(int k, int c) { const int kk = (k & ~0xC) | ((k & 4) << 1) | ((k & 8) >> 1); return ((kk >> 3) * 4 + (c >> 5)) * 512 + ((kk & 7) * 32 + (c & 31)) * 2; }
__device__ __forceinline__ int v_rd_base(int lane) { return ((lane & 3) << 3) | (((lane >> 2) & 3) << 6) | (((lane >> 4) & 1) << 5) | (((lane >> 5) & 1) << 8); }
constexpr int v_rd_off(int d0, int ks, int half) { return d0 * 512 + ks * 4096 + half * 2048; }
template <int OFF> __device__ __forceinline__ s16x4 tr_read(int vb) {
  s16x4 r; asm volatile("ds_read_b64_tr_b16 %0, %1 offset:%2" : "=&v"(r) : "v"(vb), "i"(OFF) : "memory"); return r;
}
#define PKV(L, H) (bf16x8){L[0], L[1], L[2], L[3], H[0], H[1], H[2], H[3]}
template <int D0> __device__ __forceinline__ void pv_one(f32x16& od, int vb, bf16x8 pa0, bf16x8 pa1, bf16x8 pa2, bf16x8 pa3) {
  const s16x4 l0 = tr_read<v_rd_off(D0, 0, 0)>(vb), h0 = tr_read<v_rd_off(D0, 0, 1)>(vb), l1 = tr_read<v_rd_off(D0, 1, 0)>(vb), h1 = tr_read<v_rd_off(D0, 1, 1)>(vb);
  const s16x4 l2 = tr_read<v_rd_off(D0, 2, 0)>(vb), h2 = tr_read<v_rd_off(D0, 2, 1)>(vb), l3 = tr_read<v_rd_off(D0, 3, 0)>(vb), h3 = tr_read<v_rd_off(D0, 3, 1)>(vb);
  asm volatile("s_waitcnt lgkmcnt(0)" ::: "memory"); SBAR();
  od = __builtin_amdgcn_mfma_f32_32x32x16_bf16(pa0, PKV(l0, h0), od, 0, 0, 0);
  od = __builtin_amdgcn_mfma_f32_32x32x16_bf16(pa1, PKV(l1, h1), od, 0, 0, 0);
  od = __builtin_amdgcn_mfma_f32_32x32x16_bf16(pa2, PKV(l2, h2), od, 0, 0, 0);
  od = __builtin_amdgcn_mfma_f32_32x32x16_bf16(pa3, PKV(l3, h3), od, 0, 0, 0);
}
__device__ __forceinline__ void pv_d0(f32x16* o, int vb, bf16x8 pa0, bf16x8 pa1, bf16x8 pa2, bf16x8 pa3) {
  pv_one<0>(o[0], vb, pa0, pa1, pa2, pa3); pv_one<1>(o[1], vb, pa0, pa1, pa2, pa3); pv_one<2>(o[2], vb, pa0, pa1, pa2, pa3); pv_one<3>(o[3], vb, pa0, pa1, pa2, pa3);
}

constexpr int SHM_V = 64 * 128 * 2, SHM_K = 64 * 128 * 2;
__device__ __forceinline__ void attn_unit(const bf16* __restrict__ Qb, const bf16* __restrict__ Kh, const bf16* __restrict__ Vh, const bf16* __restrict__ Gb, bf16* __restrict__ Ob, char* lds) {
  int tid = threadIdx.x; asm volatile("" : "+v"(tid));
  const int wid = tid >> 6, lane = tid & 63, r32 = lane & 31, hi = lane >> 5;
  char* V_lds = lds; char* K_lds = lds + 2 * SHM_V;
  float* ws = (float*)(lds + 2 * SHM_V + 2 * SHM_K) + wid * 64; float* li_l = ws; float* al_l = ws + 32;
  float m_reg = -1e30f, l_reg = 0; f32x16 o[4] = {}; bf16x8 qr[8];
  const bf16* Qw = Qb + (size_t)(wid * 32 + r32) * LDP + hi * 8;
#pragma unroll
  for (int d0 = 0; d0 < 8; ++d0) qr[d0] = ld8(Qw + d0 * 16);
  const int sr = tid >> 4, sc = (tid & 15) * 8, vst0 = v_st(sr, sc), vst1 = v_st(32 + sr, sc);
  const int vb0 = (int)(uintptr_t)V_lds + v_rd_base(lane);
  struct { bf16x8 vs0, vs1, ks0, ks1; } sr_[2];
#define SLOAD(i, k0) do { sr_[i].vs0 = ld8(&Vh[(size_t)((k0) + sr) * LDP + sc]); sr_[i].vs1 = ld8(&Vh[(size_t)((k0) + 32 + sr) * LDP + sc]); \
    sr_[i].ks0 = ld8(&Kh[(size_t)((k0) + sr) * LDP + sc]); sr_[i].ks1 = ld8(&Kh[(size_t)((k0) + 32 + sr) * LDP + sc]); } while (0)
#define SWRITE(b, i) do { *(bf16x8*)(V_lds + (b) * SHM_V + vst0) = sr_[i].vs0;          \
    *(bf16x8*)(V_lds + (b) * SHM_V + vst1) = sr_[i].vs1; int kc = sc * 2;               \
    *(bf16x8*)(K_lds + (b) * SHM_K + KSWZ(sr, kc)) = sr_[i].ks0;                       \
    *(bf16x8*)(K_lds + (b) * SHM_K + KSWZ(32 + sr, kc)) = sr_[i].ks1; } while (0)
#define SWAIT() asm volatile("s_waitcnt vmcnt(4)" ::: "memory")
#define RESC(a) do { if (__any((a) < 1.f)) { if (hi == 0) al_l[r32] = (a); asm volatile("s_waitcnt lgkmcnt(0)" ::: "memory"); \
    _Pragma("unroll") for (int d = 0; d < 4; ++d) _Pragma("unroll") for (int r = 0; r < 16; ++r) o[d][r] *= al_l[crow(r, hi)]; } } while (0)
  f32x16 pA0, pA1, pB0, pB1; float mnA, mnB, alA, alB; bf16x8 pa0, pa1, pa2, pa3; constexpr int NT = SEQ / 64;
  SLOAD(0, 0); asm volatile("s_waitcnt vmcnt(0)" ::: "memory"); SWRITE(0, 0); __syncthreads();
  qkt(pA0, pA1, K_lds, qr, r32, hi); partialSM(pA0, pA1, m_reg, mnA, alA);
  SLOAD(1, 64); SLOAD(0, 128);
  SWAIT(); SWRITE(1, 1); __syncthreads();
  for (int j = 1; j + 1 < NT; j += 2) {
    SBAR(); qkt(pB0, pB1, K_lds + SHM_K, qr, r32, hi);
    finishSM(pA0, pA1, alA, l_reg, pa0, pa1, pa2, pa3); SBAR();
    SLOAD(1, (j + 2) * 64); SBAR();
    pv_d0(o, vb0, pa0, pa1, pa2, pa3); partialSM(pB0, pB1, m_reg, mnB, alB);
    __syncthreads(); SWAIT(); SWRITE(0, 0);
    RESC(alB); __syncthreads();
    SBAR(); qkt(pA0, pA1, K_lds, qr, r32, hi);
    finishSM(pB0, pB1, alB, l_reg, pa0, pa1, pa2, pa3); SBAR();
    if (j + 3 < NT) SLOAD(0, (j + 3) * 64); SBAR();
    pv_d0(o, vb0 + SHM_V, pa0, pa1, pa2, pa3); partialSM(pA0, pA1, m_reg, mnA, alA);
    __syncthreads(); SWAIT(); SWRITE(1, 1);
    RESC(alA); __syncthreads();
  }
  SBAR(); qkt(pB0, pB1, K_lds + SHM_K, qr, r32, hi);
  finishSM(pA0, pA1, alA, l_reg, pa0, pa1, pa2, pa3); SBAR();
  pv_d0(o, vb0, pa0, pa1, pa2, pa3); partialSM(pB0, pB1, m_reg, mnB, alB);
  __syncthreads(); RESC(alB);
  finishSM(pB0, pB1, alB, l_reg, pa0, pa1, pa2, pa3); SBAR();
  pv_d0(o, vb0 + SHM_V, pa0, pa1, pa2, pa3);
  if (hi == 0) li_l[r32] = l_reg; asm volatile("s_waitcnt lgkmcnt(0)" ::: "memory");
  float rli[16];
#pragma unroll
  for (int r = 0; r < 16; ++r) rli[r] = __builtin_amdgcn_rcpf(li_l[crow(r, hi)]);
  __syncthreads();
  { unsigned short* stg = (unsigned short*)(lds + wid * 8192);
#pragma unroll
    for (int r = 0; r < 16; ++r) { const int orow = crow(r, hi);
#pragma unroll
      for (int d0 = 0; d0 < 4; ++d0) stg[orow * 128 + d0 * 32 + r32] = f2bf1(o[d0][r] * rli[r]); }
    asm volatile("s_waitcnt lgkmcnt(0)" ::: "memory");
    const int er = lane >> 4, ec = (lane & 15) * 8;
    const bf16* Gw = Gb + (size_t)(wid * 32 + er) * LDP + ec; bf16* Ow = Ob + (size_t)(wid * 32 + er) * DM + ec;
#pragma unroll
    for (int i = 0; i < 8; ++i) { float ov[8], gv[8]; unpack8(*(const bf16x8*)(stg + (i * 4 + er) * 128 + ec), ov); unpack8(ld8(Gw + (size_t)(i * 4) * LDP), gv);
#pragma unroll
      for (int e = 0; e < 8; ++e) ov[e] *= silu_f(gv[e]);
      *(bf16x8*)(Ow + (size_t)(i * 4) * DM) = pack8(ov); asm volatile("" ::: "memory"); } }
  __syncthreads();
#undef SLOAD
#undef SWRITE
#undef SWAIT
#undef RESC
}

__device__ __forceinline__ s16x4 tr_read_rt(int addr) { s16x4 r; asm volatile("ds_read_b64_tr_b16 %0, %1" : "=&v"(r) : "v"(addr) : "memory"); return r; }
__device__ __forceinline__ void scan_unit(int b, int h, int dir, int es, const bf16* __restrict__ PROJ, bf16* __restrict__ FST, float lg2, char* lds) {
  int tid = threadIdx.x; asm volatile("" : "+v"(tid));
  const int wid = tid >> 6, lane = tid & 63, r32 = lane & 31, hi = lane >> 5, db = wid & 3, eb = wid >> 2;
  char* Kl = lds; char* Vl = lds + 32768;
  const int vbK = (int)(uintptr_t)Kl + v_rd_base(lane) + db * 512, vbV = (int)(uintptr_t)Vl + v_rd_base(lane) + eb * 512;
  const float gC = __builtin_amdgcn_exp2f(lg2 * 128.f);
  const int sr = tid >> 4, sc = (tid & 15) * 8;
  const bf16* Kg = PROJ + (size_t)(b * SEQ) * LDP + C_RK + h * 128;
  const bf16* Vg = PROJ + (size_t)(b * SEQ) * LDP + C_RV + h * 256 + es * 64;
  bf16* Fbase = FST + ((((size_t)dir * BATCH + b) * RH + h) * NCH) * 32768 + es * 64 + eb * 32 + r32;
  f32x16 acc = {};
  bf16x8 kreg[4], vreg[2];
#define SC_LOAD(j) do { const size_t rb_ = (size_t)(j) * 128; \
    _Pragma("unroll") for (int q_ = 0; q_ < 4; ++q_) kreg[q_] = ld8(Kg + (rb_ + (q_ >> 1) * 64 + sr + 32 * (q_ & 1)) * LDP + sc); \
    _Pragma("unroll") for (int i_ = 0; i_ < 2; ++i_) { const int p_ = tid + 512 * i_; vreg[i_] = ld8(Vg + (rb_ + (p_ >> 3)) * LDP + (p_ & 7) * 8); } } while (0)
#define SC_WRITE() do { \
    _Pragma("unroll") for (int q_ = 0; q_ < 4; ++q_) { const int row_ = sr + 32 * (q_ & 1), m_ = (q_ >> 1) * 64 + row_; \
        const float z_ = __builtin_amdgcn_exp2f(lg2 * (float)(dir ? m_ : 127 - m_)); *(bf16x8*)(Kl + (q_ >> 1) * 16384 + v_st(row_, sc)) = scale8(kreg[q_], z_); } \
    _Pragma("unroll") for (int i_ = 0; i_ < 2; ++i_) { const int p_ = tid + 512 * i_, m_ = p_ >> 3; *(bf16x8*)(Vl + (m_ >> 6) * 16384 + v_st(m_ & 63, (p_ & 7) * 8)) = vreg[i_]; } } while (0)
  SC_LOAD(dir ? NCH - 1 : 0);
  for (int step = 0; step < NCH; ++step) {
    const int j = dir ? NCH - 1 - step : step;
    bf16* Fd = Fbase + (size_t)j * 32768;
#pragma unroll
    for (int r = 0; r < 16; ++r) Fd[(db * 32 + crow(r, hi)) * 256] = f2bf1(acc[r]);
    if (step == NCH - 1) break;
    __syncthreads();
    SC_WRITE();
    __syncthreads();
    if (step + 1 < NCH - 1) SC_LOAD(dir ? NCH - 2 - step : step + 1);
#pragma unroll
    for (int r = 0; r < 16; ++r) acc[r] *= gC;
#pragma unroll
    for (int kt = 0; kt < 2; ++kt)
#pragma unroll
      for (int ks = 0; ks < 4; ++ks) {
        const s16x4 al = tr_read_rt(vbK + kt * 16384 + v_rd_off(0, ks, 0)), ah = tr_read_rt(vbK + kt * 16384 + v_rd_off(0, ks, 1));
        const s16x4 bl = tr_read_rt(vbV + kt * 16384 + v_rd_off(0, ks, 0)), bh = tr_read_rt(vbV + kt * 16384 + v_rd_off(0, ks, 1));
        asm volatile("s_waitcnt lgkmcnt(0)" ::: "memory"); SBAR();
        acc = __builtin_amdgcn_mfma_f32_32x32x16_bf16(PKV(al, ah), PKV(bl, bh), acc, 0, 0, 0);
      }
  }
  __syncthreads();
#undef SC_LOAD
#undef SC_WRITE
}

__device__ __forceinline__ void ret_out_unit(int b, int h, int j, const bf16* __restrict__ PROJ, const bf16* __restrict__ FST, bf16* __restrict__ MIX, const float* __restrict__ gn, float lgf2, float lgb2, char* lds) {
  int tid = threadIdx.x; asm volatile("" : "+v"(tid));
  const int wid = tid >> 6, lane = tid & 63, r32 = lane & 31, hi = lane >> 5, qw = wid & 3, ch = wid >> 2;
  char* Kl = lds; char* Vb = lds + 32768; float* ssx = (float*)(lds + 98304);
  const size_t row0 = (size_t)b * SEQ + (size_t)j * 128;
  const int nq = qw * 32 + r32;
  const bf16* Qw = PROJ + (row0 + nq) * LDP + C_RQ + h * 128 + hi * 8;
  bf16x8 qr[8];
#pragma unroll
  for (int d0 = 0; d0 < 8; ++d0) qr[d0] = ld8(Qw + d0 * 16);
  const int sr = tid >> 4, sc = (tid & 15) * 8;
  const bf16* Kg = PROJ + row0 * LDP + C_RK + h * 128;
  const bf16* Vg = PROJ + row0 * LDP + C_RV + h * 256;
  const bf16* Fg = FST + ((((size_t)0 * BATCH + b) * RH + h) * NCH + j) * 32768;
  const bf16* Gg = FST + ((((size_t)1 * BATCH + b) * RH + h) * NCH + j) * 32768;
  const int vb0 = (int)(uintptr_t)Vb + v_rd_base(lane) + ch * 16384;
  bf16x8 vst[4];
#define VT_LOAD(t) do { const bf16* s_ = (t) < 2 ? Vg + (size_t)((t) * 64) * LDP : ((t) < 4 ? Fg + ((t) - 2) * 64 * 256 : Gg + ((t) - 4) * 64 * 256); const size_t ld_ = (t) < 2 ? (size_t)LDP : (size_t)256; \
    _Pragma("unroll") for (int q_ = 0; q_ < 4; ++q_) vst[q_] = ld8(s_ + (size_t)(sr + 32 * (q_ & 1)) * ld_ + (q_ >> 1) * 128 + sc); } while (0)
#define VT_WRITE(bf) do { _Pragma("unroll") for (int q_ = 0; q_ < 4; ++q_) *(bf16x8*)(Vb + (bf) * 32768 + (q_ >> 1) * 16384 + v_st(sr + 32 * (q_ & 1), sc)) = vst[q_]; } while (0)
  { bf16x8 kst[4];
#pragma unroll
    for (int q_ = 0; q_ < 4; ++q_) kst[q_] = ld8(Kg + (size_t)((q_ >> 1) * 64 + sr + 32 * (q_ & 1)) * LDP + sc);
    VT_LOAD(0);
#pragma unroll
    for (int q_ = 0; q_ < 4; ++q_) *(bf16x8*)(Kl + (q_ >> 1) * 16384 + KSWZ(sr + 32 * (q_ & 1), sc * 2)) = kst[q_];
    VT_WRITE(0); }
  __syncthreads();
  f32x16 o[4] = {};
  bf16x8 pa0, pa1, pa2, pa3;
  float fnq = (float)(nq - 4 * hi); asm volatile("" : "+v"(fnq));
  const float nlgb2 = -lgb2;
#pragma unroll
  for (int t = 0; t < 2; ++t) {
    VT_LOAD(t + 1);
    f32x16 p0, p1;
    qkt(p0, p1, Kl + t * 16384, qr, r32, hi);
#pragma unroll
    for (int r = 0; r < 16; ++r) {
      const float df0 = fnq - (float)(t * 64 + (r & 3) + 8 * (r >> 2)), df1 = df0 - 32.f;
      p0[r] *= __builtin_amdgcn_exp2f(fminf(lgf2 * df0, nlgb2 * df0));
      p1[r] *= __builtin_amdgcn_exp2f(fminf(lgf2 * df1, nlgb2 * df1));
    }
    PK4(p0, 0, pa0); PK4(p0, 8, pa1); PK4(p1, 0, pa2); PK4(p1, 8, pa3);
    SBAR();
    pv_d0(o, vb0 + (t & 1) * 32768, pa0, pa1, pa2, pa3);
    VT_WRITE((t + 1) & 1); __syncthreads();
  }
  const float xif = __builtin_amdgcn_exp2f(lgf2 * (float)(nq + 1)), xib = __builtin_amdgcn_exp2f(lgb2 * (float)(128 - nq));
#pragma unroll
  for (int t = 2; t < 6; ++t) {
    if (t < 5) VT_LOAD(t + 1);
    const float xs = t < 4 ? xif : xib; const int dt = t & 1;
    pa0 = scale8(qr[4 * dt + 0], xs); pa1 = scale8(qr[4 * dt + 1], xs); pa2 = scale8(qr[4 * dt + 2], xs); pa3 = scale8(qr[4 * dt + 3], xs);
    SBAR();
    pv_d0(o, vb0 + (t & 1) * 32768, pa0, pa1, pa2, pa3);
    if (t < 5) { VT_WRITE((t + 1) & 1); __syncthreads(); }
  }
  float ssq[16];
#pragma unroll
  for (int r = 0; r < 16; ++r) { float s = o[0][r] * o[0][r] + o[1][r] * o[1][r] + o[2][r] * o[2][r] + o[3][r] * o[3][r];
    s += __shfl_xor(s, 1); s += __shfl_xor(s, 2); s += __shfl_xor(s, 4); s += __shfl_xor(s, 8); s += __shfl_xor(s, 16); ssq[r] = s; }
  if (r32 == 0) {
#pragma unroll
    for (int r = 0; r < 16; ++r) ssx[(qw * 32 + crow(r, hi)) * 2 + ch] = ssq[r];
  }
  __syncthreads();
  { unsigned short* stg = (unsigned short*)(lds + wid * 8192);
    float gcol[4];
#pragma unroll
    for (int d0 = 0; d0 < 4; ++d0) gcol[d0] = gn[ch * 128 + d0 * 32 + r32];
#pragma unroll
    for (int r = 0; r < 16; ++r) { const int row = qw * 32 + crow(r, hi); const float rstd = 1.0f / sqrtf((ssx[row * 2] + ssx[row * 2 + 1]) * (1.f / 256.f) + EPS);
#pragma unroll
      for (int d0 = 0; d0 < 4; ++d0) stg[crow(r, hi) * 128 + d0 * 32 + r32] = f2bf1(o[d0][r] * rstd * gcol[d0]); }
    asm volatile("s_waitcnt lgkmcnt(0)" ::: "memory");
    const int er = lane >> 4, ec = (lane & 15) * 8;
    const bf16* Gw = PROJ + (row0 + qw * 32 + er) * LDP + C_RG + h * 256 + ch * 128 + ec; bf16* Ow = MIX + (row0 + qw * 32 + er) * DM + 2048 + h * 256 + ch * 128 + ec;
#pragma unroll
    for (int i = 0; i < 8; ++i) { float ov[8], gv[8]; unpack8(*(const bf16x8*)(stg + (i * 4 + er) * 128 + ec), ov); unpack8(ld8(Gw + (size_t)(i * 4) * LDP), gv);
#pragma unroll
      for (int e = 0; e < 8; ++e) ov[e] *= silu_f(gv[e]);
      *(bf16x8*)(Ow + (size_t)(i * 4) * DM) = pack8(ov); asm volatile("" ::: "memory"); } }
  __syncthreads();
#undef VT_LOAD
#undef VT_WRITE
}

struct Frame {
    LAS unsigned char* lds;
    volatile LAS unsigned* MISC;
    gu32* ctl;
    int tid, lane, wave;
    int vcu, G;
};

__device__ __forceinline__ void p0_transpose_item(const float* W, int K, int N, bf16* WT, LAS float* scr, int item, int lane) {
    const int nblk = N / 32, kb = item / nblk, nb = item % nblk, k0 = 64 * kb, n0 = 32 * nb;
#pragma unroll 8
    for (int i = 0; i < 32; ++i) { const int kk = 2 * i + (lane >> 5); scr[kk * 33 + (lane & 31)] = W[(size_t)(k0 + kk) * N + n0 + (lane & 31)]; }
    LDS_WAIT(); asm volatile("" ::: "memory");
    const int c = lane & 7;
#pragma unroll
    for (int j = 0; j < 4; ++j) { const int n = (lane >> 3) + 8 * j; const LAS float* s = scr + (8 * c) * 33 + n;
        v4u o; o.x = pk2(s[0 * 33], s[1 * 33]); o.y = pk2(s[2 * 33], s[3 * 33]); o.z = pk2(s[4 * 33], s[5 * 33]); o.w = pk2(s[6 * 33], s[7 * 33]);
        *(GAS v4u*)(WT + (size_t)(n0 + n) * K + k0 + 8 * c) = o; }
    LDS_WAIT(); asm volatile("" ::: "memory");
}
__device__ __forceinline__ void rms_row_to_bf16(const float* xrow, const float* g, bf16* orow, int lane) {
    const GAS f32x4* xr = (const GAS f32x4*)xrow + lane;
    f32x4 v[16]; float s = 0.f;
#pragma unroll
    for (int j = 0; j < 16; ++j) { v[j] = xr[64 * j]; s += (v[j].x * v[j].x + v[j].y * v[j].y) + (v[j].z * v[j].z + v[j].w * v[j].w); }
    const float rstd = 1.f / sqrtf(wave_sum(s) * (1.f / DM) + EPS);
    GAS unsigned long long* o8 = (GAS unsigned long long*)orow + lane;
    const GAS f32x4* gr = (const GAS f32x4*)g + lane;
#pragma unroll
    for (int j = 0; j < 16; ++j) { const f32x4 gg = gr[64 * j]; o8[64 * j] = (unsigned long long)cvtpk(v[j].x * rstd * gg.x, v[j].y * rstd * gg.y) | ((unsigned long long)cvtpk(v[j].z * rstd * gg.z, v[j].w * rstd * gg.w) << 32); }
}
__device__ __forceinline__ void rms_row_to_f32(const float* xrow, const float* g, float* orow, int lane, bool poison) {
    const GAS f32x4* xr = (const GAS f32x4*)xrow + lane;
    f32x4 v[16]; float s = 0.f;
#pragma unroll
    for (int j = 0; j < 16; ++j) { v[j] = xr[64 * j]; s += (v[j].x * v[j].x + v[j].y * v[j].y) + (v[j].z * v[j].z + v[j].w * v[j].w); }
    float rstd = 1.f / sqrtf(wave_sum(s) * (1.f / DM) + EPS);
    if (poison) rstd = __builtin_nanf("");
    GAS f32x4* o4 = (GAS f32x4*)orow + lane;
    const GAS f32x4* gr = (const GAS f32x4*)g + lane;
#pragma unroll
    for (int j = 0; j < 16; ++j) { const f32x4 gg = gr[64 * j]; o4[64 * j] = v[j] * rstd * gg; }
}

struct Args { const float* in[10]; float* out; unsigned char* ws; int ph_lo, ph_hi; };

__global__ void __launch_bounds__(NWAVES * 64, 2) hymba_fwd(Args args) {
    extern __shared__ __attribute__((aligned(16))) unsigned char lds[];
    Frame F;
    F.lds = (LAS unsigned char*)lds;
    F.MISC = (volatile LAS unsigned*)(F.lds + MISC_OFF);
    F.tid = threadIdx.x; F.lane = F.tid & 63; F.wave = __builtin_amdgcn_readfirstlane(F.tid >> 6);
    F.G = gridDim.x; { const int bx = blockIdx.x; F.vcu = (F.G % 8 == 0) ? (bx % 8) * (F.G / 8) + bx / 8 : bx; }
    unsigned char* ws = args.ws;
    F.ctl = (gu32*)(ws + WS_CTL);
    const float* x_in = args.in[0]; const float* norm_w = args.in[1]; const float* w_in = args.in[2]; const float* q_norm = args.in[3]; const float* k_norm = args.in[4];
    const float* dec_f = args.in[5]; const float* dec_b = args.in[6]; const float* ret_norm = args.in[7]; const float* w_out = args.in[8]; const float* final_norm = args.in[9];
    float* ROPE = (float*)(ws + WS_ROPE);
    bf16* WIN = (bf16*)(ws + WS_WIN); bf16* WOUT = (bf16*)(ws + WS_WOUT); float* XCUR = (float*)(ws + WS_XCUR); bf16* XN = (bf16*)(ws + WS_XN);
    bf16* PROJ = (bf16*)(ws + WS_PROJ); bf16* MIX = (bf16*)(ws + WS_MIX); bf16* FST = (bf16*)(ws + WS_FST);
    for (int u = F.tid; u < (LDS_BYTES - LDSCTL_OFF) / 4; u += NWAVES * 64) ((LAS unsigned*)(F.lds + LDSCTL_OFF))[u] = 0u;
    __syncthreads();
    XcdBarrier bar; bar.bar = (unsigned*)(F.ctl + CW_BAR); bar.x = 0; bar.st = nullptr;
    if (!MK_PER_PHASE) bar = xcd_barrier_post((unsigned*)(F.ctl + CW_BAR), F.MISC + 8);
#define GRID_BAR() do { if (!MK_PER_PHASE) xcd_barrier(bar); } while (0)
    const int lo = args.ph_lo, hi = args.ph_hi;
#define IN(k) (lo <= (k) && (k) < hi)
#define BOTH(k) (IN(k) && IN((k) + 1))
    const int gw = F.vcu * NWAVES + F.wave, NGW = F.G * NWAVES;

    if (PH_EN(0) && IN(0)) {
        LAS float* scr = (LAS float*)(F.lds + F.wave * 16384);
        constexpr int I_IN = (DM / 64) * (NIN / 32), I_OUT = (DM / 64) * (DM / 32), I_L = I_IN + I_OUT;
        for (int it = gw; it < DEPTH * I_L; it += NGW) {
            const int l = it / I_L, r = it % I_L;
            if (r < I_IN) p0_transpose_item(w_in + (size_t)l * DM * NIN, DM, NIN, WIN + (size_t)l * NIN * DM, scr, r, F.lane);
            else p0_transpose_item(w_out + (size_t)l * DM * DM, DM, DM, WOUT + (size_t)l * DM * DM, scr, r - I_IN, F.lane);
        }
        const int gt = blockIdx.x * (NWAVES * 64) + F.tid;
        if (gt < 2048) {
            const int pos = gt >> 5, jf = gt & 31;
            double inv = 1.0; for (int i = 0; i < jf; ++i) inv *= 0.74989420933245582730;
            const float angf = (float)pos * (float)inv;
            const double a = (double)angf, kq = __builtin_rint(a * 0.63661977236758134308), rr = (a - kq * 1.5707963267948966192) - kq * 6.123233995736766e-17, r2 = rr * rr;
            const double sn = rr * (1.0 + r2 * (-1.0 / 6 + r2 * (1.0 / 120 + r2 * (-1.0 / 5040 + r2 * (1.0 / 362880 + r2 * (-1.0 / 39916800 + r2 * (1.0 / 6227020800.0)))))));
            const double cs = 1.0 + r2 * (-0.5 + r2 * (1.0 / 24 + r2 * (-1.0 / 720 + r2 * (1.0 / 40320 + r2 * (-1.0 / 3628800 + r2 * (1.0 / 479001600.0 + r2 * (-1.0 / 87178291200.0)))))));
            const int qd = ((int)kq) & 3;
            const double c = qd == 0 ? cs : qd == 1 ? -sn : qd == 2 ? -cs : sn, s = qd == 0 ? sn : qd == 1 ? cs : qd == 2 ? -sn : -cs;
            ROPE[gt] = (float)c; ROPE[2048 + gt] = (float)s;
        }
        if (BOTH(0)) GRID_BAR();
    }

    for (int l = 0; l < DEPTH; ++l) {
        const int pb = 1 + 6 * l;
        const float* xsrc = (l == 0) ? x_in : XCUR;
        if (PH_EN(1) && IN(pb)) {
            int ln = F.lane; asm volatile("" : "+v"(ln));
            int gwn = gw; asm volatile("" : "+s"(gwn));
            for (int m = gwn; m < M; m += NGW) rms_row_to_bf16(xsrc + (size_t)m * DM, norm_w + (size_t)l * DM, XN + (size_t)m * DM, ln);
            if (BOTH(pb)) GRID_BAR();
        }
        if (PH_EN(2) && IN(pb + 1)) {
            pg8::Gemm g{XN, WIN + (size_t)l * NIN * DM, M, NIN, DM}; pg8::StaticOrder S; S.init(M, NIN, F.G, (int)blockIdx.x);
            pg8::EpiBf16<0> E{PROJ, NIN, nullptr, 0, 0, 1.f};
            pg8::gemm_phase<pg8::EpiBf16<0>, pg8::StaticOrder, true, true>(F.lds, g, S, E);
            if (BOTH(pb + 1)) GRID_BAR();
        }
        if (PH_EN(3) && IN(pb + 2)) {
            const float* qn = q_norm + l * 128; const float* kn = k_norm + l * 128;
            int ln = F.lane; asm volatile("" : "+v"(ln));
            const int hs = ln >> 3, sub = ln & 7, half = sub >> 2, chunk = sub & 3;
            int gwp = gw; asm volatile("" : "+s"(gwp));
            for (int it = gwp; it < M * 5; it += NGW) {
                const int tok = it / 5, grp = it % 5, hidx = grp * 8 + hs; const bool valid = hidx < 36;
                int colbase, type;
                if (hidx < 16) { colbase = C_AQ + hidx * 128; type = 0; } else if (hidx < 20) { colbase = C_AK + (hidx - 16) * 128; type = 1; }
                else if (hidx < 28) { colbase = C_RQ + (hidx - 20) * 128; type = 2; } else { colbase = C_RK + (hidx - 28) * 128; type = 3; }
                const int dd = 64 * half + 8 * chunk;
                bf16* p = PROJ + (size_t)tok * LDP + colbase + dd;
                float a[8], bq[8];
                if (valid) { unpack8(ld8(p), a); unpack8(ld8(p + 32), bq); }
                else {
#pragma unroll
                    for (int i = 0; i < 8; ++i) { a[i] = 0.f; bq[i] = 0.f; } }
                float ss = 0.f;
#pragma unroll
                for (int i = 0; i < 8; ++i) ss += a[i] * a[i] + bq[i] * bq[i];
                ss += __shfl_xor(ss, 1); ss += __shfl_xor(ss, 2); ss += __shfl_xor(ss, 4);
                float rs = 1.f;
                if (type < 2) rs = 1.f / sqrtf(ss * (1.f / 128.f) + EPS); else if (type == 3) rs = ATT_SCALE;
                const float* gsrc = type == 0 ? qn : kn;
                const int s = tok & (SEQ - 1), pos = half ? (s & 63) : (s >> 6);
                const float* ct = ROPE + pos * 32 + 8 * chunk; const float* st = ct + 2048;
                float o1[8], o2[8];
#pragma unroll
                for (int i = 0; i < 8; ++i) {
                    float g1 = 1.f, g2 = 1.f; if (type < 2) { g1 = gsrc[dd + i]; g2 = gsrc[dd + 32 + i]; }
                    const float y1 = a[i] * rs * g1, y2 = bq[i] * rs * g2, c = ct[i], sn = st[i];
                    o1[i] = y1 * c - y2 * sn; o2[i] = y1 * sn + y2 * c;
                }
                if (valid) { *(bf16x8*)p = pack8(o1); *(bf16x8*)(p + 32) = pack8(o2); }
            }
            if (BOTH(pb + 2)) GRID_BAR();
        }
        if (PH_EN(4) && IN(pb + 3)) {
            for (int u = F.vcu; u < BATCH * RH * 2 * 4; u += F.G) {
                const int es = u & 3, dir = (u >> 2) & 1, h = (u >> 3) & 7, b = u >> 6;
                const float lg2 = log2_sigmoid((dir ? dec_b : dec_f)[l * RH + h]);
                scan_unit(b, h, dir, es, PROJ, FST, lg2, (char*)lds);
            }
            if (BOTH(pb + 3)) GRID_BAR();
        }
        if (PH_EN(5) && IN(pb + 4)) {
            if (PH_EN(8)) for (int u = F.vcu; u < BATCH * NHQ * (SEQ / 256); u += F.G) {
                const int qb = u & 15, g = (u >> 4) & 3, bk = u >> 6, kvh = bk & 3, b = bk >> 2, head = kvh * 4 + g;
                const size_t r0 = (size_t)b * SEQ + (size_t)qb * 256, k0 = (size_t)b * SEQ;
                attn_unit(PROJ + r0 * LDP + C_AQ + head * 128, PROJ + k0 * LDP + C_AK + kvh * 128, PROJ + k0 * LDP + C_AV + kvh * 128, PROJ + r0 * LDP + C_AG + head * 128, MIX + r0 * DM + head * 128, (char*)lds);
            }
            if (PH_EN(9)) for (int u = F.vcu; u < BATCH * RH * NCH; u += F.G) {
                const int j = u & 31, h = (u >> 5) & 7, b = u >> 8;
                const float lgf2 = log2_sigmoid(dec_f[l * RH + h]), lgb2 = log2_sigmoid(dec_b[l * RH + h]);
                ret_out_unit(b, h, j, PROJ, FST, MIX, ret_norm + ((size_t)l * RH + h) * 256, lgf2, lgb2, (char*)lds);
            }
            if (BOTH(pb + 4)) GRID_BAR();
        }
        if (PH_EN(6) && IN(pb + 5)) {
            pg8::Gemm g{MIX, WOUT + (size_t)l * DM * DM, M, DM, DM}; pg8::StaticOrder S; S.init(M, DM, F.G, (int)blockIdx.x);
            pg8::EpiResF32 E{xsrc, XCUR, DM};
            pg8::gemm_phase<pg8::EpiResF32, pg8::StaticOrder, true, true>(F.lds, g, S, E);
            if (BOTH(pb + 5)) GRID_BAR();
        }
    }
    if (PH_EN(7) && IN(NPH - 1)) {
        const bool poison = !MK_PER_PHASE && (xb_ld(&bar.bar[XB_TMO]) != 0u);
        int gwf = gw; asm volatile("" : "+s"(gwf));
        for (int m = gwf; m < M; m += NGW) rms_row_to_f32(XCUR + (size_t)m * DM, final_norm, args.out + (size_t)m * DM, F.lane, poison);
    }
#undef IN
#undef BOTH
#undef GRID_BAR
}

extern "C" void kernel_launch(void* const* d_in, const int* in_sizes, int n_in, void* d_out, int out_size, void* d_ws, size_t ws_size, hipStream_t stream) {
    static int grid = 0;
    if (grid == 0) {
        if (n_in != 10 || in_sizes[0] != M * DM || out_size != M * DM || ws_size < WS_END) {
            fprintf(stderr, "kernel_launch: shape/workspace mismatch: n_in %d in0 %d out %d ws %zu (need %zu); nothing launched\n", n_in, n_in > 0 ? in_sizes[0] : -1, out_size, ws_size, (size_t)WS_END); grid = -1; return; }
        int dev = 0, cus = 0, per_cu = 0;
        if (hipGetDevice(&dev) != hipSuccess || hipDeviceGetAttribute(&cus, hipDeviceAttributeMultiprocessorCount, dev) != hipSuccess) { fprintf(stderr, "kernel_launch: device query failed\n"); grid = -1; return; }
        if (hipFuncSetAttribute((const void*)hymba_fwd, hipFuncAttributeMaxDynamicSharedMemorySize, LDS_BYTES) != hipSuccess) { fprintf(stderr, "kernel_launch: hipFuncSetAttribute failed\n"); grid = -1; return; }
        if (hipOccupancyMaxActiveBlocksPerMultiprocessor(&per_cu, (const void*)hymba_fwd, NWAVES * 64, LDS_BYTES) != hipSuccess || per_cu < 1)
            fprintf(stderr, "kernel_launch: note: occupancy query reports %d workgroups per CU\n", per_cu);
        (void)hipGetLastError();
        grid = cus;
    }
    if (grid < 0) return;
    if (hipMemsetAsync((char*)d_ws + WS_CTL, 0, CTL_ZERO_BYTES, stream) != hipSuccess) { fprintf(stderr, "kernel_launch: memset failed\n"); return; }
    Args a{};
    for (int i = 0; i < 10; ++i) a.in[i] = (const float*)d_in[i];
    a.out = (float*)d_out; a.ws = (unsigned char*)d_ws;
#if MK_PER_PHASE
    for (int p = 0; p < NPH; ++p) { a.ph_lo = p; a.ph_hi = p + 1; hipLaunchKernelGGL(hymba_fwd, dim3(grid), dim3(NWAVES * 64), LDS_BYTES, stream, a); }
#else
    a.ph_lo = 0; a.ph_hi = NPH; hipLaunchKernelGGL(hymba_fwd, dim3(grid), dim3(NWAVES * 64), LDS_BYTES, stream, a);
#endif
    const hipError_t le = hipPeekAtLastError();
    if (le != hipSuccess) fprintf(stderr, "kernel_launch: launch failed: %s\n", hipGetErrorName(le));
}
```

```cpp
#include <hip/hip_runtime.h>
#include <cstdio>
#include <cstdint>
namespace pg8 {
#define PG8_LAS __attribute__((address_space(3)))
typedef unsigned short bf16_t;
typedef short bf16x8 __attribute__((ext_vector_type(8)));
typedef float f32x4 __attribute__((ext_vector_type(4)));
typedef unsigned u32x4 __attribute__((ext_vector_type(4)));
constexpr int BM = 256, BK = 64, HALF = 128, HTB = HALF * BK * 2  , STAGE_BYTES = 8 * HTB, NXCD = 8, WGM = 8;

__host__ __device__ __forceinline__ int lds_byte(int r, int c) { const int st = (r >> 4) * 2 + (c >> 5), rr = r & 15, cc = c & 31, ob = rr * 64 + cc * 2; return st * 1024 + (ob ^ (((ob >> 9) & 1) << 5)); }
__host__ __device__ __forceinline__ void stage_rc(int b, int& R, int& C) { const int st = b / 1024, sb = b % 1024, swz = sb ^ (((sb >> 9) & 1) << 5); R = (st >> 1) * 16 + swz / 64; C = (st & 1) * 32 + (swz % 64) / 2; }
__host__ __device__ __forceinline__ int perm32(int rho) { const int n = rho >> 4, i = rho & 15; return 8 * (i >> 2) + 4 * n + (i & 3); }

struct Unit { int pm, pn; };
struct Gemm { const bf16_t* A; const bf16_t* Bt; int M, N, K, ld; };

struct StaticOrder {
    int nM, nN, nwg, G, c, i0, i1;
    __host__ __device__ void init(int M, int N, int G_, int c_) { nM = M / BM; nN = N / BM; nwg = nM * nN; G = G_; c = c_; i0 = 0; i1 = 1 << 30; }
    __host__ __device__ bool next(int i, Unit& u) const {
        const int ii = i + i0; if (ii >= i1) return false;
        const long L = (long)ii * G + c; if (L >= nwg) return false;
        int wgid = (int)L; { const int q = nwg / NXCD, r = nwg % NXCD, xcd = wgid % NXCD, off = wgid / NXCD; wgid = (xcd < r ? xcd * (q + 1) : r * (q + 1) + (xcd - r) * q) + off; }
        const int nig = WGM * nN, gid = wgid / nig, fm = gid * WGM, gsz = (nM - fm) < WGM ? (nM - fm) : WGM;
        u.pm = fm + ((wgid % nig) % gsz); u.pn = (wgid % nig) / gsz; return true;
    }
    __device__ __forceinline__ void a_ready(const Unit&) const {}
    __device__ __forceinline__ void done(const Unit&) const {}
};

typedef float cvt_f32x2 __attribute__((ext_vector_type(2))); typedef __bf16 cvt_bf16x2 __attribute__((ext_vector_type(2)));
__device__ __forceinline__ unsigned cvt_pk_bf16(float lo, float hi) { cvt_f32x2 v = {lo, hi}; cvt_bf16x2 r = __builtin_convertvector(v, cvt_bf16x2); return __builtin_bit_cast(unsigned, r); }
typedef float f32x2 __attribute__((ext_vector_type(2)));
__device__ __forceinline__ f32x2 gelu_pk(f32x2 v) {
    const f32x2 av = __builtin_elementwise_abs(v), d = av * 0.2316418882f + 1.0f;
    f32x2 t; t.x = __builtin_amdgcn_rcpf(d.x); t.y = __builtin_amdgcn_rcpf(d.y);
    f32x2 q = t * 0.5307027145f + (-0.7265760135f); q = q * t + 0.7107068705f; q = q * t + (-0.142248368f); q = q * t + 0.127414796f; q = q * t;
    const f32x2 s = (v * v) * (-0.72134752044f);
    f32x2 e; e.x = __builtin_amdgcn_exp2f(s.x); e.y = __builtin_amdgcn_exp2f(s.y);
    const f32x2 m = v * (q * e), r = v - m;
    f32x2 o; o.x = v.x < 0.f ? m.x : r.x; o.y = v.y < 0.f ? m.y : r.y; return o;
}

template <int ACT  > struct EpiBf16 {
    static constexpr bool PERM = true, AFTER_DRAIN = false; static_assert(ACT == 0 || ACT == 1, "EpiBf16: ACT is 0 (none) or 1 (gelu_pk)");
    bf16_t* O; int ldc; const float* bias; int split_cols; size_t split_stride; float scale0;
    __device__ __forceinline__ void operator()(const f32x4 (&acc)[2][2][4][2], const Unit& u, int wr, int wc, int fr, int fq) const {
        const int row0 = u.pm * BM + wr * 64 + fr; int colt = u.pn * BM; bf16_t* base = O;
        float sc = 1.f; if (split_cols) { const int t = colt / split_cols; base += (size_t)t * split_stride; colt -= t * split_cols; if (t == 0) sc = scale0; }
        const int col0 = colt + wc * 32 + 8 * fq, bcol0 = u.pn * BM + wc * 32 + 8 * fq;
        f32x4 bv[2][2];
#pragma unroll
        for (int bj = 0; bj < 2; ++bj)
#pragma unroll
            for (int n = 0; n < 2; ++n) bv[bj][n] = bias ? *(const f32x4*)(bias + bcol0 + bj * HALF + 4 * n) : (f32x4){0.f, 0.f, 0.f, 0.f};
#pragma unroll
        for (int ai = 0; ai < 2; ++ai)
#pragma unroll
            for (int m = 0; m < 4; ++m) { bf16_t* rowp = base + (size_t)(row0 + ai * HALF + m * 16) * ldc + col0;
#pragma unroll
                for (int bj = 0; bj < 2; ++bj) { f32x4 v0 = acc[ai][bj][m][0] + bv[bj][0], v1 = acc[ai][bj][m][1] + bv[bj][1];
                    if (ACT == 1) { f32x2 a = gelu_pk((f32x2){v0[0], v0[1]}), b = gelu_pk((f32x2){v0[2], v0[3]}), c = gelu_pk((f32x2){v1[0], v1[1]}), d = gelu_pk((f32x2){v1[2], v1[3]});
                        v0 = (f32x4){a.x, a.y, b.x, b.y}; v1 = (f32x4){c.x, c.y, d.x, d.y}; }
                    v0 = v0 * sc; v1 = v1 * sc; u32x4 w; w.x = cvt_pk_bf16(v0[0], v0[1]); w.y = cvt_pk_bf16(v0[2], v0[3]); w.z = cvt_pk_bf16(v1[0], v1[1]); w.w = cvt_pk_bf16(v1[2], v1[3]);
                    *(u32x4*)(rowp + bj * HALF) = w; } }
    }
};
template <class Epi, class Sched, bool ALIGN_EPI = false, bool SP2 = false>
__device__ __forceinline__ void gemm_phase(PG8_LAS unsigned char* lds, const Gemm g, const Sched& S, const Epi& E) {
    int tid_ = threadIdx.x; asm volatile("" : "+v"(tid_));
    const int tid = tid_, wid = __builtin_amdgcn_readfirstlane(tid >> 6), lane = tid & 63, wr = wid >> 2, wc = wid & 3, fr = lane & 15, fq = lane >> 4;
    const int K = g.K, nt = K / BK, LD = g.ld;
    unsigned voffA[2], voffB[2];
#pragma unroll
    for (int i = 0; i < 2; ++i) { int R, C; stage_rc(tid * 16 + i * 8192, R, C); const int Rb = Epi::PERM ? ((R & ~31) + perm32(R & 31)) : R;
        voffA[i] = (unsigned)(R * LD + C) * 2u; voffB[i] = (unsigned)(Rb * LD + C) * 2u; }
    const size_t kstep = (size_t)(BK * 2);
    const size_t hstep = (size_t)HALF * LD * 2;
    const size_t tstep = 2 * hstep;
    const unsigned ldsw = (unsigned)wid * 1024u;
    const int aoff = lds_byte(wr * 64 + fr, fq * 8), boff = lds_byte(wc * 32 + fr, fq * 8);
#define PG8_SA(b, h) (((b) * 2 + (h)) * HTB)
#define PG8_SB(b, h) ((4 + (b) * 2 + (h)) * HTB)
#define PG8_STAGE(bufoff, gbase, voff) do { _Pragma("unroll") for (int _i = 0; _i < 2; ++_i) \
        __builtin_amdgcn_global_load_lds((const unsigned*)((const char*)(gbase) + (voff)[_i]), (PG8_LAS unsigned*)(lds + (bufoff) + ldsw + _i * 8192), 16, 0, 0); } while (0)
#define PG8_STAGE_K(bufoff, gbase, voff, keep) do { _Pragma("unroll") for (int _i = 0; _i < 2; ++_i) { keep[_i] = (const char*)(gbase) + (voff)[_i]; \
        __builtin_amdgcn_global_load_lds((const unsigned*)keep[_i], (PG8_LAS unsigned*)(lds + (bufoff) + ldsw + _i * 8192), 16, 0, 0); } } while (0)
#define PG8_STAGE_R(bufoff, keep) do { _Pragma("unroll") for (int _i = 0; _i < 2; ++_i) \
        __builtin_amdgcn_global_load_lds((const unsigned*)keep[_i], (PG8_LAS unsigned*)(lds + (bufoff) + ldsw + _i * 8192 - BK * 2), 16, BK * 2, 0); } while (0)
#define PG8_LDA(dst, b, h) do { _Pragma("unroll") for (int m = 0; m < 4; ++m) _Pragma("unroll") for (int k = 0; k < 2; ++k) dst[m][k] = *(const PG8_LAS bf16x8*)(lds + PG8_SA(b, h) + aoff + m * 2048 + k * 1024); } while (0)
#define PG8_LDB(dst, b, h) do { _Pragma("unroll") for (int n = 0; n < 2; ++n) _Pragma("unroll") for (int k = 0; k < 2; ++k) dst[n][k] = *(const PG8_LAS bf16x8*)(lds + PG8_SB(b, h) + boff + n * 2048 + k * 1024); } while (0)
#define PG8_MMA(ai, bj, At, Bt) do { __builtin_amdgcn_s_setprio(1); _Pragma("unroll") for (int m = 0; m < 4; ++m) _Pragma("unroll") for (int n = 0; n < 2; ++n) _Pragma("unroll") for (int k = 0; k < 2; ++k) \
        acc[ai][bj][m][n] = __builtin_amdgcn_mfma_f32_16x16x32_bf16(Bt[n][k], At[m][k], acc[ai][bj][m][n], 0, 0, 0); __builtin_amdgcn_s_setprio(0); } while (0)
#define PG8_WAIT_V(n) asm volatile("s_waitcnt vmcnt(" #n ")" ::: "memory")
#define PG8_WAIT_L(n) asm volatile("s_waitcnt lgkmcnt(" #n ")" ::: "memory")
#define PG8_BAR __builtin_amdgcn_s_barrier()
#define PG8_SCHED __builtin_amdgcn_sched_barrier(0)
    Unit cur, nxt; int ui = 0;
    if (!S.next(0, cur)) return;
    f32x4 acc[2][2][4][2];
#pragma unroll
    for (int a = 0; a < 2; ++a)
#pragma unroll
        for (int b = 0; b < 2; ++b)
#pragma unroll
            for (int m = 0; m < 4; ++m)
#pragma unroll
                for (int n = 0; n < 2; ++n) acc[a][b][m][n] = (f32x4){0.f, 0.f, 0.f, 0.f};
    bf16x8 At[4][2], B0[2][2], B1[2][2];
    const char* cA = (const char*)g.A + (size_t)cur.pm * tstep; const char* cB = (const char*)g.Bt + (size_t)cur.pn * tstep;
    S.a_ready(cur);
    if constexpr (SP2) {
        PG8_STAGE(PG8_SB(0, 0), cB, voffB); PG8_STAGE(PG8_SB(0, 1), cB + hstep, voffB); PG8_STAGE(PG8_SA(0, 0), cA, voffA); PG8_STAGE(PG8_SA(0, 1), cA + hstep, voffA);
        if (wr == 1) PG8_BAR;
        PG8_WAIT_V(2); PG8_BAR;
        PG8_STAGE(PG8_SB(1, 0), cB + kstep, voffB); PG8_STAGE(PG8_SA(1, 0), cA + kstep, voffA); PG8_STAGE(PG8_SB(1, 1), cB + hstep + kstep, voffB);
        PG8_WAIT_V(6); PG8_BAR;
    } else {
        PG8_STAGE(PG8_SB(0, 0), cB, voffB); PG8_STAGE(PG8_SA(0, 0), cA, voffA); PG8_STAGE(PG8_SB(0, 1), cB + hstep, voffB); PG8_STAGE(PG8_SA(0, 1), cA + hstep, voffA);
        if (wr == 1) PG8_BAR;
        PG8_WAIT_V(4); PG8_BAR;
        PG8_STAGE(PG8_SB(1, 0), cB + kstep, voffB); PG8_STAGE(PG8_SA(1, 0), cA + kstep, voffA); PG8_STAGE(PG8_SB(1, 1), cB + hstep + kstep, voffB);
        PG8_WAIT_V(6); PG8_BAR;
    }
    const char* kA0[2]; const char* kA1[2]; const char* kB0[2]; const char* kB1[2];
    if constexpr (SP2) { kA1[0] = cA + hstep + voffA[0]; kA1[1] = cA + hstep + voffA[1]; }
    for (;;) {
        const bool has_next = S.next(ui + 1, nxt);
        const char* nA = has_next ? (const char*)g.A + (size_t)nxt.pm * tstep : cA; const char* nB = has_next ? (const char*)g.Bt + (size_t)nxt.pn * tstep : cB;
        for (int t = 0; t < nt; t += 2) {
            const bool last = (t == nt - 2);
            const char* a1 = cA + (size_t)(t + 1) * kstep;
            const char* a2 = last ? nA : cA + (size_t)(t + 2) * kstep; const char* b2 = last ? nB : cB + (size_t)(t + 2) * kstep;
            const char* a3 = a2 + kstep; const char* b3 = b2 + kstep;
            if (last && has_next) S.a_ready(nxt);
            if constexpr (SP2) {
            PG8_LDB(B0, 0, 0); PG8_LDB(B1, 0, 1); PG8_SCHED; PG8_LDA(At, 0, 0); PG8_STAGE_R(PG8_SA(1, 1), kA1);
            PG8_WAIT_V(8); PG8_WAIT_L(0); PG8_BAR; PG8_MMA(0, 0, At, B0); PG8_MMA(0, 1, At, B1); PG8_BAR; PG8_SCHED;
            PG8_LDA(At, 0, 1); PG8_STAGE_K(PG8_SB(0, 0), b2, voffB, kB0); PG8_STAGE_K(PG8_SB(0, 1), b2 + hstep, voffB, kB1); PG8_STAGE_K(PG8_SA(0, 0), a2, voffA, kA0);
            PG8_WAIT_V(8); PG8_WAIT_L(0); PG8_BAR; PG8_MMA(1, 0, At, B0); PG8_MMA(1, 1, At, B1); PG8_BAR; PG8_SCHED;
            PG8_LDB(B0, 1, 0); PG8_LDB(B1, 1, 1); PG8_SCHED; PG8_LDA(At, 1, 0); PG8_STAGE_K(PG8_SA(0, 1), a2 + hstep, voffA, kA1);
            PG8_WAIT_V(8); PG8_WAIT_L(0); PG8_BAR; PG8_MMA(0, 0, At, B0); PG8_MMA(0, 1, At, B1); PG8_BAR; PG8_SCHED;
            PG8_LDA(At, 1, 1); PG8_STAGE_R(PG8_SB(1, 0), kB0); PG8_STAGE_R(PG8_SB(1, 1), kB1); PG8_STAGE_R(PG8_SA(1, 0), kA0);
            PG8_WAIT_V(8); PG8_WAIT_L(0); PG8_BAR; PG8_MMA(1, 0, At, B0); PG8_MMA(1, 1, At, B1); PG8_BAR; PG8_SCHED;
            } else {
            PG8_LDB(B0, 0, 0); PG8_SCHED; PG8_LDA(At, 0, 0); PG8_STAGE(PG8_SA(1, 1), a1 + hstep, voffA);
            PG8_WAIT_L(8); PG8_BAR; PG8_WAIT_L(0); PG8_MMA(0, 0, At, B0); PG8_BAR; PG8_SCHED;
            PG8_LDB(B1, 0, 1); PG8_STAGE(PG8_SB(0, 0), b2, voffB);
            PG8_BAR; PG8_WAIT_L(0); PG8_MMA(0, 1, At, B1); PG8_BAR;
            PG8_LDA(At, 0, 1); PG8_STAGE(PG8_SA(0, 0), a2, voffA);
            PG8_BAR; PG8_WAIT_L(0); PG8_MMA(1, 0, At, B0); PG8_BAR; PG8_SCHED;
            PG8_STAGE(PG8_SB(0, 1), b2 + hstep, voffB);
            PG8_WAIT_V(6); PG8_BAR; PG8_MMA(1, 1, At, B1); PG8_BAR;
            PG8_LDB(B0, 1, 0); PG8_SCHED; PG8_LDA(At, 1, 0); PG8_STAGE(PG8_SA(0, 1), a2 + hstep, voffA);
            PG8_WAIT_L(8); PG8_BAR; PG8_WAIT_L(0); PG8_MMA(0, 0, At, B0); PG8_BAR; PG8_SCHED;
            PG8_LDB(B1, 1, 1); PG8_STAGE(PG8_SB(1, 0), b3, voffB);
            PG8_BAR; PG8_WAIT_L(0); PG8_MMA(0, 1, At, B1); PG8_BAR;
            PG8_LDA(At, 1, 1); PG8_STAGE(PG8_SA(1, 0), a3, voffA);
            PG8_BAR; PG8_WAIT_L(0); PG8_MMA(1, 0, At, B0); PG8_BAR; PG8_SCHED;
            PG8_STAGE(PG8_SB(1, 1), b3 + hstep, voffB);
            PG8_WAIT_V(6); PG8_BAR; PG8_MMA(1, 1, At, B1); PG8_BAR;
            }
        }
        if constexpr (ALIGN_EPI) { if (wr == 0) PG8_BAR; }
        if constexpr (!Epi::AFTER_DRAIN) { E(acc, cur, wr, wc, fr, fq); S.done(cur); }
        if (!has_next) break;
#pragma unroll
        for (int a = 0; a < 2; ++a)
#pragma unroll
            for (int b = 0; b < 2; ++b)
#pragma unroll
                for (int m = 0; m < 4; ++m)
#pragma unroll
                    for (int n = 0; n < 2; ++n) acc[a][b][m][n] = (f32x4){0.f, 0.f, 0.f, 0.f};
        cur = nxt; cA = nA; cB = nB; ++ui;
        if constexpr (ALIGN_EPI) { if (wr == 1) PG8_BAR; }
    }
    PG8_WAIT_V(0);
    if constexpr (!ALIGN_EPI) { if (wr == 0) PG8_BAR; }
    PG8_BAR;
    if constexpr (Epi::AFTER_DRAIN) { E.fused(acc, cur, wr, wc, fr, fq, lds, wid, lane); S.done(cur); }
#undef PG8_SA
#undef PG8_SB
#undef PG8_STAGE
#undef PG8_STAGE_K
#undef PG8_STAGE_R
#undef PG8_LDA
#undef PG8_LDB
#undef PG8_MMA
#undef PG8_WAIT_V
#undef PG8_WAIT_L
#undef PG8_BAR
#undef PG8_SCHED
}
}
namespace pg8 {
__device__ __forceinline__ float opq(float x) { asm("" : "+v"(x)); return x; }
__device__ __forceinline__ float row4_sum(float v) {
    { auto r = __builtin_amdgcn_permlane16_swap(__float_as_uint(v), __float_as_uint(v), false, false); v = __uint_as_float(r[0]) + __uint_as_float(r[1]); }
    { auto r = __builtin_amdgcn_permlane32_swap(__float_as_uint(v), __float_as_uint(v), false, false); v = __uint_as_float(r[0]) + __uint_as_float(r[1]); }
    return v;
}
struct EpiResF32 {
    static constexpr bool PERM = false, AFTER_DRAIN = false;
    const float* base; float* out; int ldc;
    __device__ __forceinline__ void operator()(const f32x4 (&acc)[2][2][4][2], const Unit& u, int wr, int wc, int fr, int fq) const {
        const int row0 = u.pm * BM + wr * 64 + fr, col0 = u.pn * BM + wc * 32 + 4 * fq;
#pragma unroll
        for (int ai = 0; ai < 2; ++ai)
#pragma unroll
            for (int m = 0; m < 4; ++m) { const size_t off = (size_t)(row0 + ai * HALF + m * 16) * ldc + col0;
#pragma unroll
                for (int bj = 0; bj < 2; ++bj)
#pragma unroll
                    for (int n = 0; n < 2; ++n) { const f32x4 bs = *(const f32x4*)(base + off + bj * HALF + n * 16); *(f32x4*)(out + off + bj * HALF + n * 16) = bs + acc[ai][bj][m][n]; }
                asm volatile("" ::: "memory"); }
    }
};
struct EpiResBf16 {
    static constexpr bool PERM = true, AFTER_DRAIN = false;
    bf16_t* xb; int ld; float* ssx;
    __device__ __forceinline__ void operator()(const f32x4 (&acc)[2][2][4][2], const Unit& u, int wr, int wc, int fr, int fq) const {
        const int row0 = u.pm * BM + wr * 64 + fr, col0 = u.pn * BM + wc * 32 + 8 * fq;
        u32x4 bs[2][4][2];
#pragma unroll
        for (int ai = 0; ai < 2; ++ai)
#pragma unroll
            for (int m = 0; m < 4; ++m)
#pragma unroll
                for (int bj = 0; bj < 2; ++bj) bs[ai][m][bj] = *(const u32x4*)(xb + (size_t)(row0 + ai * HALF + m * 16) * ld + col0 + bj * HALF);
        asm volatile("" ::: "memory");
#pragma unroll
        for (int ai = 0; ai < 2; ++ai)
#pragma unroll
            for (int m = 0; m < 4; ++m) { const int row = row0 + ai * HALF + m * 16; bf16_t* rowp = xb + (size_t)row * ld + col0; float ss = 0.f;
#pragma unroll
                for (int bj = 0; bj < 2; ++bj) { const u32x4 b = bs[ai][m][bj]; const f32x4 a0 = acc[ai][bj][m][0], a1 = acc[ai][bj][m][1];
                    const f32x4 t0 = {opq(__uint_as_float(b.x << 16) + a0[0]), opq(__uint_as_float(b.x & 0xffff0000u) + a0[1]), opq(__uint_as_float(b.y << 16) + a0[2]), opq(__uint_as_float(b.y & 0xffff0000u) + a0[3])};
                    const f32x4 t1 = {opq(__uint_as_float(b.z << 16) + a1[0]), opq(__uint_as_float(b.z & 0xffff0000u) + a1[1]), opq(__uint_as_float(b.w << 16) + a1[2]), opq(__uint_as_float(b.w & 0xffff0000u) + a1[3])};
                    u32x4 w; w.x = cvt_pk_bf16(t0[0], t0[1]); w.y = cvt_pk_bf16(t0[2], t0[3]); w.z = cvt_pk_bf16(t1[0], t1[1]); w.w = cvt_pk_bf16(t1[2], t1[3]);
                    *(u32x4*)(rowp + bj * HALF) = w;
                    ss = fmaf(t0[0], t0[0], ss); ss = fmaf(t0[1], t0[1], ss); ss = fmaf(t0[2], t0[2], ss); ss = fmaf(t0[3], t0[3], ss); ss = fmaf(t1[0], t1[0], ss); ss = fmaf(t1[1], t1[1], ss); ss = fmaf(t1[2], t1[2], ss); ss = fmaf(t1[3], t1[3], ss); }
                ss = row4_sum(ss);
                if (fq == 0) ssx[(size_t)row * 64 + u.pn * 4 + wc] = ss; }
    }
};
struct EpiProj {
    static constexpr bool PERM = true, AFTER_DRAIN = false;
    bf16_t *QC, *KC, *VC, *RQC, *RKC, *GA, *RV, *GR; float *ssq, *ssk; PG8_LAS const float* rope; PG8_LAS const float* qn; PG8_LAS const float* kn; PG8_LAS const float* rs;
    __device__ __forceinline__ void operator()(const f32x4 (&acc)[2][2][4][2], const Unit& u, int wr, int wc, int fr, int fq) const {
        constexpr int SEQ_ = 4096; constexpr float RSC = 0.088388347648318440f;
        const int pn = u.pn, bb = (u.pm * BM) >> 12, srow0 = ((u.pm * BM) & (SEQ_ - 1)) + wr * 64 + fr;
        int mode, nh = 0, hd = 0; bf16_t* base; size_t rowpitch, bjstride; float* ssp = nullptr; PG8_LAS const float* gsrc = nullptr; float rsc = 1.f;
        if (pn < 8)       { mode = 2; nh = 16; hd = 2 * pn;        base = QC + (size_t)(bb * 16 + hd) * SEQ_ * 128; rowpitch = 128; bjstride = (size_t)SEQ_ * 128; ssp = ssq; gsrc = qn; }
        else if (pn < 10) { mode = 2; nh = 4;  hd = 2 * (pn - 8);  base = KC + (size_t)(bb * 4 + hd) * SEQ_ * 128;  rowpitch = 128; bjstride = (size_t)SEQ_ * 128; ssp = ssk; gsrc = kn; }
        else if (pn < 12) { mode = 0;          hd = 2 * (pn - 10); base = VC + (size_t)(bb * 4 + hd) * SEQ_ * 128;  rowpitch = 128; bjstride = (size_t)SEQ_ * 128; }
        else if (pn < 20) { mode = 0;          hd = 2 * (pn - 12); base = GA + (size_t)(bb * 16 + hd) * SEQ_ * 128; rowpitch = 128; bjstride = (size_t)SEQ_ * 128; }
        else if (pn < 24) { mode = 1;          hd = 2 * (pn - 20); base = RQC + (size_t)(bb * 8 + hd) * SEQ_ * 128; rowpitch = 128; bjstride = (size_t)SEQ_ * 128; }
        else if (pn < 28) { mode = 1;          hd = 2 * (pn - 24); base = RKC + (size_t)(bb * 8 + hd) * SEQ_ * 128; rowpitch = 128; bjstride = (size_t)SEQ_ * 128; rsc = RSC; }
        else if (pn < 36) { mode = 0; base = RV + (size_t)(bb * 8 + (pn - 28)) * SEQ_ * 256; rowpitch = 256; bjstride = 128; }
        else              { mode = 0; base = GR + (size_t)(bb * 8 + (pn - 36)) * SEQ_ * 256; rowpitch = 256; bjstride = 128; }
        bf16_t* const dst0 = base + wc * 32 + 8 * fq;
        PG8_LAS const float* const rsp = rs + (u.pm & 7) * BM + wr * 64 + fr;
        if (mode == 0) {
#pragma unroll
            for (int ai = 0; ai < 2; ++ai)
#pragma unroll
                for (int m = 0; m < 4; ++m) { bf16_t* rowp = dst0 + (size_t)(srow0 + ai * HALF + m * 16) * rowpitch; const float rr = rsp[ai * HALF + m * 16];
#pragma unroll
                    for (int bj = 0; bj < 2; ++bj) { const f32x4 a0 = acc[ai][bj][m][0], a1 = acc[ai][bj][m][1];
                        u32x4 w; w.x = cvt_pk_bf16(opq(a0[0] * rr), opq(a0[1] * rr)); w.y = cvt_pk_bf16(opq(a0[2] * rr), opq(a0[3] * rr)); w.z = cvt_pk_bf16(opq(a1[0] * rr), opq(a1[1] * rr)); w.w = cvt_pk_bf16(opq(a1[2] * rr), opq(a1[3] * rr));
                        *(u32x4*)(rowp + bj * bjstride) = w; } }
            return;
        }
        const int hb = wc >> 1, j0 = 16 * (wc & 1) + 4 * fq;
        f32x4 g1 = {1.f, 1.f, 1.f, 1.f}, g2 = g1;
        if (mode == 2) { g1 = *(PG8_LAS const f32x4*)(gsrc + 64 * hb + j0); g2 = *(PG8_LAS const f32x4*)(gsrc + 64 * hb + 32 + j0); }
#pragma unroll
        for (int ai = 0; ai < 2; ++ai) {
            f32x4 cs[4], sn[4]; float rr[4];
#pragma unroll
            for (int m = 0; m < 4; ++m) { const int s = srow0 + ai * HALF + m * 16, pos = hb ? (s & 63) : (s >> 6); cs[m] = *(PG8_LAS const f32x4*)(rope + pos * 32 + j0); sn[m] = *(PG8_LAS const f32x4*)(rope + 2048 + pos * 32 + j0); rr[m] = rsp[ai * HALF + m * 16]; }
#pragma unroll
            for (int m = 0; m < 4; ++m) { const int s = srow0 + ai * HALF + m * 16; bf16_t* rowp = dst0 + (size_t)s * rowpitch; const float rq = rr[m] * rsc; f32x4 h1, h2;
#pragma unroll
                for (int i = 0; i < 4; ++i) { h1[i] = opq(g1[i] * rq); h2[i] = opq(g2[i] * rq); }
#pragma unroll
                for (int bj = 0; bj < 2; ++bj) { const f32x4 x1 = acc[ai][bj][m][0], x2 = acc[ai][bj][m][1];
                    f32x4 o1, o2;
#pragma unroll
                    for (int i = 0; i < 4; ++i) { const float y1 = opq(x1[i] * h1[i]), y2 = opq(x2[i] * h2[i]), c = cs[m][i], sv = sn[m][i]; o1[i] = opq(fmaf(y1, c, -opq(y2 * sv))); o2[i] = opq(fmaf(y1, sv, opq(y2 * c))); }
                    u32x4 w; w.x = cvt_pk_bf16(o1[0], o1[1]); w.y = cvt_pk_bf16(o1[2], o1[3]); w.z = cvt_pk_bf16(o2[0], o2[1]); w.w = cvt_pk_bf16(o2[2], o2[3]);
                    *(u32x4*)(rowp + bj * bjstride) = w;
                    if (mode == 2) { float ss = x1[0] * x1[0];
                        ss = fmaf(x1[1], x1[1], ss); ss = fmaf(x1[2], x1[2], ss); ss = fmaf(x1[3], x1[3], ss); ss = fmaf(x2[0], x2[0], ss); ss = fmaf(x2[1], x2[1], ss); ss = fmaf(x2[2], x2[2], ss); ss = fmaf(x2[3], x2[3], ss);
                        ss = row4_sum(ss);
                        if (fq == 0) ssp[(((size_t)bb * SEQ_ + s) * nh + hd + bj) * 4 + wc] = ss * (rr[m] * rr[m]); } } }
        }
    }
};
}
#define GAS __attribute__((address_space(1)))
#define LAS __attribute__((address_space(3)))
typedef unsigned short bf16;
typedef unsigned v4u __attribute__((ext_vector_type(4)));
typedef float f32x4 __attribute__((ext_vector_type(4)));
typedef short bf16x8 __attribute__((ext_vector_type(8)));
typedef GAS unsigned gu32;
typedef GAS unsigned long long gu64;
#define RLX_AGENT __ATOMIC_RELAXED, __HIP_MEMORY_SCOPE_AGENT
#define LDS_WAIT() asm volatile("s_waitcnt lgkmcnt(0)" ::: "memory")
#define VM_WAIT() asm volatile("s_waitcnt vmcnt(0)" ::: "memory")
__device__ __forceinline__ unsigned long long rt() { return __builtin_amdgcn_s_memrealtime(); }
__device__ __forceinline__ unsigned f2bf(float f) { unsigned u = __builtin_bit_cast(unsigned, f); return (u + 0x7fffu + ((u >> 16) & 1u)) >> 16; }
__device__ __forceinline__ unsigned pk2(float lo, float hi) { return f2bf(lo) | (f2bf(hi) << 16); }

#define XB_TMO      128
#define XB_XCNT(j)  (256  + 64 * (j))
#define XB_XSUB(j)  (1280 + 64 * (j))
#define XB_XGEN(j)  (2304 + 64 * (j))
#define XB_TOP      3328
#define XB_TOPGEN   3392
#define XCD_BAR_WORDS 3456
#define XB_SPIN_CAP (1u << 18)

__device__ __forceinline__ unsigned xb_ld(unsigned* p)              { return __hip_atomic_load(p, __ATOMIC_RELAXED, __HIP_MEMORY_SCOPE_AGENT); }
__device__ __forceinline__ unsigned xb_add(unsigned* p, unsigned v) { return __hip_atomic_fetch_add(p, v, __ATOMIC_RELAXED, __HIP_MEMORY_SCOPE_AGENT); }
__device__ __forceinline__ unsigned xb_xcc_id() { return (unsigned)__builtin_amdgcn_s_getreg((3 << 11) | 20) & 0xFu; }
#define XB_SPIN(cond, bar) do { unsigned _sp = 0; while (cond) { __builtin_amdgcn_s_sleep(1); \
    if ((++_sp & 255u) == 0u) { if (xb_ld(&(bar)[XB_TMO])) break; if (_sp > XB_SPIN_CAP) { atomicAdd(&(bar)[XB_TMO], 1u); break; } } } } while (0)

struct XcdBarrier {
    unsigned* bar; unsigned x;
    volatile LAS unsigned* st;
};

__device__ __forceinline__ XcdBarrier xcd_barrier_post(unsigned* bar, volatile LAS unsigned* st) {
    XcdBarrier b; b.bar = bar; b.x = xb_xcc_id(); b.st = st;
    if (threadIdx.x == 0) (void)xb_add(&bar[XB_XCNT(b.x)], 1u);
    return b;
}
__device__ __forceinline__ void xcd_barrier_complete(unsigned* bar, unsigned x, unsigned& nloc, unsigned& nx) {
    const unsigned G = gridDim.x * gridDim.y * gridDim.z;
    unsigned sum, cnt, mine, sp = 0u;
    for (;;) {
        sum = 0u; cnt = 0u; mine = 0u;
#pragma unroll
        for (unsigned j = 0; j < 16; ++j) { const unsigned c = xb_ld(&bar[XB_XCNT(j)]); sum += c; cnt += (c > 0u) ? 1u : 0u; mine = (j == x) ? c : mine; }
        if (sum == G) break;
        __builtin_amdgcn_s_sleep(1);
        if ((++sp & 255u) == 0u) { if (xb_ld(&bar[XB_TMO])) break; if (sp > XB_SPIN_CAP) { atomicAdd(&bar[XB_TMO], 1u); break; } }
    }
    nloc = mine > 0u ? mine : 1u; nx = cnt > 0u ? cnt : 1u;
}

__device__ __forceinline__ void xcd_barrier(const XcdBarrier& b) {
    asm volatile("s_waitcnt vmcnt(0)" ::: "memory");
    __syncthreads();
    if (threadIdx.x == 0) {
        unsigned* bar = b.bar;
        __builtin_amdgcn_s_waitcnt(0);
        unsigned nloc = b.st[0], nx = b.st[1];
        if (nloc == 0u) { xcd_barrier_complete(bar, b.x, nloc, nx); b.st[0] = nloc; b.st[1] = nx; }
        const unsigned old = xb_add(&bar[XB_XSUB(b.x)], 1u);
        const unsigned gen = old / nloc;
        if (old + 1u == (gen + 1u) * nloc) {
            __builtin_amdgcn_fence(__ATOMIC_RELEASE, "agent");
            asm volatile("s_waitcnt vmcnt(0)" ::: "memory");
            const unsigned og = xb_add(&bar[XB_TOP], 1u);
            const unsigned tg = og / nx;
            if (og + 1u == (tg + 1u) * nx) xb_add(&bar[XB_TOPGEN], 1u);
            else XB_SPIN(xb_ld(&bar[XB_TOPGEN]) == tg, bar);
            __builtin_amdgcn_fence(__ATOMIC_ACQUIRE, "agent");
            xb_add(&bar[XB_XGEN(b.x)], 1u);
            asm volatile("s_waitcnt vmcnt(0)" ::: "memory");
        } else {
            XB_SPIN(xb_ld(&bar[XB_XGEN(b.x)]) == gen, bar);
            __builtin_amdgcn_fence(__ATOMIC_ACQUIRE, "agent");
            asm volatile("s_waitcnt vmcnt(0)" ::: "memory");
        }
    }
    __syncthreads();
}

constexpr int BATCH = 4, SEQ = 4096, DM = 4096, DEPTH = 4, M = BATCH * SEQ;
constexpr int NIN = 11264, LDP = NIN, KP = DM;
constexpr int C_AQ = 0, C_AK = 2048, C_AV = 2560, C_AG = 3072, C_RQ = 5120, C_RK = 6144, C_RV = 7168, C_RG = 9216;
constexpr int NHQ = 16, NHKV = 4, RH = 8, NCH = SEQ / 128;
constexpr float EPS = 1e-6f;
constexpr int NWAVES = 8;
#ifndef MK_PER_PHASE
#define MK_PER_PHASE 0
#endif
constexpr int NPH = 2 + 5 * DEPTH;
#ifndef PH_MASK
#define PH_MASK 0x3ff
#endif
#define PH_EN(k) ((PH_MASK >> (k)) & 1)
#ifndef DUP_MASK
#define DUP_MASK 0
#endif
#ifndef PP16
#define PP16 1
#endif
#ifndef PP_PRIO
#define PP_PRIO 0
#endif
#ifndef ATT_PROBE
#define ATT_PROBE 0
#endif
#ifndef PP_ROLE
#define PP_ROLE(w) ((w) >> 2)
#endif
#define DUP(k) (((DUP_MASK >> (k)) & 1) ? 2 : 1)

constexpr size_t MiB = 1u << 20;
constexpr size_t WS_CTL = 0, CTL_ZERO_BYTES = 1 * MiB;
constexpr size_t WS_ROPE = 1 * MiB;
constexpr size_t WS_WIN = 2 * MiB;
constexpr size_t WS_WOUT = WS_WIN + (size_t)DEPTH * NIN * KP * 2;
constexpr size_t WS_XCUR = WS_WOUT + (size_t)DEPTH * DM * KP * 2;
constexpr size_t WS_XN = WS_XCUR + (size_t)M * DM * 2;
constexpr int GP = 2048;
constexpr size_t WS_GA = WS_XN + (size_t)M * KP * 2;
constexpr size_t WS_RV = WS_GA + (size_t)M * GP * 2;
constexpr size_t WS_GR = WS_RV + (size_t)M * GP * 2;
constexpr size_t WS_SSQ = WS_GR + (size_t)M * GP * 2;
constexpr size_t WS_SSK = WS_SSQ + (size_t)M * 16 * 4 * 4;
constexpr size_t WS_MIX = WS_SSK + (size_t)M * 4 * 4 * 4;
constexpr size_t WS_FST = WS_MIX + (size_t)M * KP * 2;
constexpr size_t WS_QC = WS_FST + (size_t)2 * BATCH * RH * NCH * 128 * 256 * 2;
constexpr size_t WS_KC = WS_QC + (size_t)M * 2048 * 2;
constexpr size_t WS_VC = WS_KC + (size_t)M * 512 * 2;
constexpr size_t WS_RQC = WS_VC + (size_t)M * 512 * 2;
constexpr size_t WS_RKC = WS_RQC + (size_t)M * 1024 * 2;
constexpr size_t WS_END = WS_RKC + (size_t)M * 1024 * 2;
constexpr int CW_QUEUE = 8192;
constexpr int CW_BAR = 4096;

constexpr int RING_BYTES = 131072;
constexpr int LDSCTL_OFF = RING_BYTES, MISC_OFF = LDSCTL_OFF + 320;
constexpr int ROPE_LDS = RING_BYTES + 1024, GAIN_LDS = ROPE_LDS + 16384;
constexpr int RSTD_LDS = GAIN_LDS + 1024;
constexpr int LDS_BYTES = RSTD_LDS + 8192;

typedef short s16x4 __attribute__((ext_vector_type(4)));
typedef float f32x16 __attribute__((ext_vector_type(16)));
typedef unsigned u32x4 __attribute__((ext_vector_type(4)));
#define SBAR() __builtin_amdgcn_sched_barrier(0)

__device__ __forceinline__ float bf2f(unsigned short x) { return __uint_as_float((unsigned)x << 16); }
typedef float f32x2_t __attribute__((ext_vector_type(2))); typedef __bf16 bf16x2_t __attribute__((ext_vector_type(2)));
__device__ __forceinline__ unsigned cvtpk(float lo, float hi) { f32x2_t v = {lo, hi}; bf16x2_t r = __builtin_convertvector(v, bf16x2_t); return __builtin_bit_cast(unsigned, r); }
__device__ __forceinline__ unsigned short f2bf1(float x) { return (unsigned short)(cvtpk(x, x) & 0xffffu); }
__device__ __forceinline__ bf16x8 ld8(const bf16* p) { return *reinterpret_cast<const bf16x8*>(p); }
__device__ __forceinline__ void unpack8(bf16x8 v, float* f) {
    const u32x4 w = __builtin_bit_cast(u32x4, v);
#pragma unroll
    for (int i = 0; i < 4; ++i) { f[2 * i] = __uint_as_float(w[i] << 16); f[2 * i + 1] = __uint_as_float(w[i] & 0xffff0000u); }
}
__device__ __forceinline__ bf16x8 pack8(const float* f) {
    u32x4 w; w.x = cvtpk(f[0], f[1]); w.y = cvtpk(f[2], f[3]); w.z = cvtpk(f[4], f[5]); w.w = cvtpk(f[6], f[7]); return __builtin_bit_cast(bf16x8, w);
}
__device__ __forceinline__ bf16x8 scale8(bf16x8 v, float s) { float f[8]; unpack8(v, f);
#pragma unroll
    for (int i = 0; i < 8; ++i) f[i] *= s;
    return pack8(f); }
__device__ __forceinline__ float silu_f(float x) { return x * __builtin_amdgcn_rcpf(1.0f + __builtin_amdgcn_exp2f(-1.4426950408889634f * x)); }
#define DPPF(x, ctrl) __uint_as_float((unsigned)__builtin_amdgcn_update_dpp(0, (int)__float_as_uint(x), ctrl, 0xf, 0xf, true))
__device__ __forceinline__ float xsum2(float v)  { return v + DPPF(v, 0xB1); }
__device__ __forceinline__ float xsum4(float v)  { v = xsum2(v); return v + DPPF(v, 0x4E); }
__device__ __forceinline__ float xsum8(float v)  { v = xsum4(v); return v + DPPF(v, 0x141); }
__device__ __forceinline__ float xsum16(float v) { v = xsum8(v); return v + DPPF(v, 0x140); }
__device__ __forceinline__ float xsum32(float v) { v = xsum16(v); auto r = __builtin_amdgcn_permlane16_swap(__float_as_uint(v), __float_as_uint(v), false, false); return __uint_as_float(r[0]) + __uint_as_float(r[1]); }
__device__ __forceinline__ float wave_sum(float v) { v = xsum32(v); auto r = __builtin_amdgcn_permlane32_swap(__float_as_uint(v), __float_as_uint(v), false, false); return __uint_as_float(r[0]) + __uint_as_float(r[1]); }
__device__ __forceinline__ float wave_max(float v) {
    v = fmaxf(v, DPPF(v, 0xB1)); v = fmaxf(v, DPPF(v, 0x4E)); v = fmaxf(v, DPPF(v, 0x141)); v = fmaxf(v, DPPF(v, 0x140));
    { auto r = __builtin_amdgcn_permlane16_swap(__float_as_uint(v), __float_as_uint(v), false, false); v = fmaxf(__uint_as_float(r[0]), __uint_as_float(r[1])); }
    { auto r = __builtin_amdgcn_permlane32_swap(__float_as_uint(v), __float_as_uint(v), false, false); v = fmaxf(__uint_as_float(r[0]), __uint_as_float(r[1])); }
    return v;
}
__device__ __forceinline__ float log2_sigmoid(float x) {
    const float y = expf(-x); float l;
    if (y < 0.25f) { const float y2 = y * y; l = y * (1.f + y * (-0.5f + y * (1.f / 3.f + y * (-0.25f + y * (0.2f + y * (-1.f / 6.f + y * (1.f / 7.f + y * (-0.125f + y * (1.f / 9.f))))))))); (void)y2; }
    else l = logf(1.f + y);
    return -l * 1.4426950408889634f;
}

#define KSWZ(row, colB) ((row) * 256 + ((colB) ^ (((row) & 7) << 4)))
__device__ __forceinline__ int crow(int r, int hi) { return (r & 3) + 8 * (r >> 2) + 4 * hi; }
constexpr float ATT_SCALE = 0.088388347648318440f;
constexpr float ATT_THR = 8.f;
__device__ __forceinline__ void partialSM(f32x16& p0, f32x16& p1, float& m_reg, float& mn, float& alpha, const float C  ) {
  float pmax = p0[0];
#pragma unroll
  for (int r = 1; r < 16; ++r) pmax = fmaxf(pmax, p0[r]);
#pragma unroll
  for (int r = 0; r < 16; ++r) pmax = fmaxf(pmax, p1[r]);
  { auto rr = __builtin_amdgcn_permlane32_swap(__float_as_uint(pmax), __float_as_uint(pmax), false, false);
    pmax = fmaxf(__uint_as_float(rr[0]), __uint_as_float(rr[1])); }
  if (__builtin_expect(__all((pmax - m_reg) * C <= ATT_THR * 1.4426950408889634f), 1)) { mn = m_reg; alpha = 1.f; }
  else { mn = fmaxf(m_reg, pmax); alpha = __builtin_amdgcn_exp2f((m_reg - mn) * C); m_reg = mn; }
  float mnC = -mn * C;
#pragma unroll
  for (int r = 0; r < 16; ++r) p0[r] = fmaf(p0[r], C, mnC);
#pragma unroll
  for (int r = 0; r < 16; ++r) p1[r] = fmaf(p1[r], C, mnC);
#pragma unroll
  for (int r = 0; r < 16; ++r) p0[r] = __builtin_amdgcn_exp2f(p0[r]);
}
#define PK4(P, BASE, OUT) do { unsigned a0 = cvtpk(P[BASE + 0], P[BASE + 1]), a1 = cvtpk(P[BASE + 2], P[BASE + 3]);   \
    unsigned b0 = cvtpk(P[BASE + 4], P[BASE + 5]), b1 = cvtpk(P[BASE + 6], P[BASE + 7]);                              \
    auto r0 = __builtin_amdgcn_permlane32_swap(a0, b0, false, false); auto r1 = __builtin_amdgcn_permlane32_swap(a1, b1, false, false); \
    u32x4 w = {r0[0], r1[0], r0[1], r1[1]}; OUT = *reinterpret_cast<bf16x8*>(&w); } while (0)
__device__ __forceinline__ void finishSM(f32x16& p0, f32x16& p1, float alpha, float& l_reg, bf16x8& pa0, bf16x8& pa1, bf16x8& pa2, bf16x8& pa3) {
#pragma unroll
  for (int r = 0; r < 16; ++r) p1[r] = __builtin_amdgcn_exp2f(p1[r]);
  float ps = 0;
#pragma unroll
  for (int r = 0; r < 16; ++r) ps += p0[r];
#pragma unroll
  for (int r = 0; r < 16; ++r) ps += p1[r];
  { auto rr = __builtin_amdgcn_permlane32_swap(__float_as_uint(ps), __float_as_uint(ps), false, false);
    ps = __uint_as_float(rr[0]) + __uint_as_float(rr[1]); }
  l_reg = l_reg * alpha + ps;
  PK4(p0, 0, pa0); PK4(p0, 8, pa1); PK4(p1, 0, pa2); PK4(p1, 8, pa3);
}
__device__ __forceinline__ void qkt(f32x16& p0, f32x16& p1, const char* Ks, const bf16x8* qr, int r32, int hi) {
  p0 = f32x16{}; p1 = f32x16{};
#pragma unroll
  for (int d0 = 0; d0 < 8; ++d0) { int cb = (d0 * 16 + hi * 8) * 2;
    bf16x8 b0 = *reinterpret_cast<const bf16x8*>(Ks + KSWZ(r32, cb));
    bf16x8 b1 = *reinterpret_cast<const bf16x8*>(Ks + KSWZ(32 + r32, cb));
    p0 = __builtin_amdgcn_mfma_f32_32x32x16_bf16(b0, qr[d0], p0, 0, 0, 0);
    p1 = __builtin_amdgcn_mfma_f32_32x32x16_bf16(b1, qr[d0], p1, 0, 0, 0); }
}
__device__ __forceinline__ int v_st(int k, int c) { const int kk = (k & ~0xC) | ((k & 4) << 1) | ((k & 8) >> 1); return ((kk >> 3) * 4 + (c >> 5)) * 512 + ((kk & 7) * 32 + (c & 31)) * 2; }
__device__ __forceinline__ int v_rd_base(int lane) { return ((lane & 3) << 3) | (((lane >> 2) & 3) << 6) | (((lane >> 4) & 1) << 5) | (((lane >> 5) & 1) << 8); }
constexpr int v_rd_off(int d0, int ks, int half) { return d0 * 512 + ks * 4096 + half * 2048; }
template <int OFF> __device__ __forceinline__ s16x4 tr_read(int vb) {
  s16x4 r; asm volatile("ds_read_b64_tr_b16 %0, %1 offset:%2" : "=&v"(r) : "v"(vb), "i"(OFF) : "memory"); return r;
}
#define PKV(L, H) (bf16x8){L[0], L[1], L[2], L[3], H[0], H[1], H[2], H[3]}
template <int D0> __device__ __forceinline__ void pv_one(f32x16& od, int vb, bf16x8 pa0, bf16x8 pa1, bf16x8 pa2, bf16x8 pa3) {
  const s16x4 l0 = tr_read<v_rd_off(D0, 0, 0)>(vb), h0 = tr_read<v_rd_off(D0, 0, 1)>(vb), l1 = tr_read<v_rd_off(D0, 1, 0)>(vb), h1 = tr_read<v_rd_off(D0, 1, 1)>(vb);
  const s16x4 l2 = tr_read<v_rd_off(D0, 2, 0)>(vb), h2 = tr_read<v_rd_off(D0, 2, 1)>(vb), l3 = tr_read<v_rd_off(D0, 3, 0)>(vb), h3 = tr_read<v_rd_off(D0, 3, 1)>(vb);
  asm volatile("s_waitcnt lgkmcnt(0)" ::: "memory"); SBAR();
  od = __builtin_amdgcn_mfma_f32_32x32x16_bf16(pa0, PKV(l0, h0), od, 0, 0, 0);
  od = __builtin_amdgcn_mfma_f32_32x32x16_bf16(pa1, PKV(l1, h1), od, 0, 0, 0);
  od = __builtin_amdgcn_mfma_f32_32x32x16_bf16(pa2, PKV(l2, h2), od, 0, 0, 0);
  od = __builtin_amdgcn_mfma_f32_32x32x16_bf16(pa3, PKV(l3, h3), od, 0, 0, 0);
}
__device__ __forceinline__ void pv_d0(f32x16* o, int vb, bf16x8 pa0, bf16x8 pa1, bf16x8 pa2, bf16x8 pa3) {
  pv_one<0>(o[0], vb, pa0, pa1, pa2, pa3); pv_one<1>(o[1], vb, pa0, pa1, pa2, pa3); pv_one<2>(o[2], vb, pa0, pa1, pa2, pa3); pv_one<3>(o[3], vb, pa0, pa1, pa2, pa3);
}

constexpr int SHM_V = 64 * 128 * 2, SHM_K = 64 * 128 * 2;
__device__ __forceinline__ void attn_unit(const bf16* __restrict__ Qb, const bf16* __restrict__ Kh, const bf16* __restrict__ Vh, const bf16* __restrict__ Gb, const float* __restrict__ ssq  , bf16* __restrict__ Ob, char* lds) {
  int tid = threadIdx.x; asm volatile("" : "+v"(tid));
  const int wid = tid >> 6, lane = tid & 63, r32 = lane & 31, hi = lane >> 5;
  char* V_lds = lds; char* K_lds = lds + 2 * SHM_V;
  float* ws = (float*)(lds + 2 * SHM_V + 2 * SHM_K) + wid * 64; float* li_l = ws; float* al_l = ws + 32;
  float m_reg = -1e30f, l_reg = 0; f32x16 o[4] = {}; bf16x8 qr[8];
  const bf16* Qw = Qb + (size_t)(wid * 32 + r32) * 128 + hi * 8;
#pragma unroll
  for (int d0 = 0; d0 < 8; ++d0) qr[d0] = ld8(Qw + d0 * 16);
  float Cq; { const f32x4 pq = *(const f32x4*)(ssq + (size_t)(wid * 32 + r32) * 64); Cq = ATT_SCALE * 1.4426950408889634f / sqrtf(((pq.x + pq.y) + (pq.z + pq.w)) * (1.f / 128.f) + EPS); }
  const int sr = tid >> 4, sc = (tid & 15) * 8, vst0 = v_st(sr, sc), vst1 = v_st(32 + sr, sc);
  const int vb0 = (int)(uintptr_t)V_lds + v_rd_base(lane);
  struct { bf16x8 vs0, vs1, ks0, ks1; } sr_[2];
#define SLOAD(i, k0) do { sr_[i].vs0 = ld8(&Vh[(size_t)((k0) + sr) * 128 + sc]); sr_[i].vs1 = ld8(&Vh[(size_t)((k0) + 32 + sr) * 128 + sc]); \
    sr_[i].ks0 = ld8(&Kh[(size_t)((k0) + sr) * 128 + sc]); sr_[i].ks1 = ld8(&Kh[(size_t)((k0) + 32 + sr) * 128 + sc]); } while (0)
#define SWRITE(b, i) do { *(bf16x8*)(V_lds + (b) * SHM_V + vst0) = sr_[i].vs0;          \
    *(bf16x8*)(V_lds + (b) * SHM_V + vst1) = sr_[i].vs1; int kc = sc * 2;               \
    *(bf16x8*)(K_lds + (b) * SHM_K + KSWZ(sr, kc)) = sr_[i].ks0;                       \
    *(bf16x8*)(K_lds + (b) * SHM_K + KSWZ(32 + sr, kc)) = sr_[i].ks1; } while (0)
#define SWAIT() asm volatile("s_waitcnt vmcnt(4)" ::: "memory")
#define RESC(a) do { if (__any((a) < 1.f)) { if (hi == 0) al_l[r32] = (a); asm volatile("s_waitcnt lgkmcnt(0)" ::: "memory"); \
    _Pragma("unroll") for (int d = 0; d < 4; ++d) _Pragma("unroll") for (int r = 0; r < 16; ++r) o[d][r] *= al_l[crow(r, hi)]; } } while (0)
  f32x16 pA0, pA1, pB0, pB1; float mnA, mnB, alA, alB; bf16x8 pa0, pa1, pa2, pa3; constexpr int NT = SEQ / 64;
  SLOAD(0, 0); asm volatile("s_waitcnt vmcnt(0)" ::: "memory"); SWRITE(0, 0); __syncthreads();
  qkt(pA0, pA1, K_lds, qr, r32, hi); partialSM(pA0, pA1, m_reg, mnA, alA, Cq);
  SLOAD(1, 64); SLOAD(0, 128);
  SWAIT(); SWRITE(1, 1); __syncthreads();
  for (int j = 1; j + 1 < NT; j += 2) {
    SBAR(); qkt(pB0, pB1, K_lds + SHM_K, qr, r32, hi);
    finishSM(pA0, pA1, alA, l_reg, pa0, pa1, pa2, pa3); SBAR();
    SLOAD(1, (j + 2) * 64); SBAR();
    pv_d0(o, vb0, pa0, pa1, pa2, pa3); partialSM(pB0, pB1, m_reg, mnB, alB, Cq);
    __syncthreads(); SWAIT(); SWRITE(0, 0);
    RESC(alB); __syncthreads();
    SBAR(); qkt(pA0, pA1, K_lds, qr, r32, hi);
    finishSM(pB0, pB1, alB, l_reg, pa0, pa1, pa2, pa3); SBAR();
    if (j + 3 < NT) SLOAD(0, (j + 3) * 64); SBAR();
    pv_d0(o, vb0 + SHM_V, pa0, pa1, pa2, pa3); partialSM(pA0, pA1, m_reg, mnA, alA, Cq);
    __syncthreads(); SWAIT(); SWRITE(1, 1);
    RESC(alA); __syncthreads();
  }
  SBAR(); qkt(pB0, pB1, K_lds + SHM_K, qr, r32, hi);
  finishSM(pA0, pA1, alA, l_reg, pa0, pa1, pa2, pa3); SBAR();
  pv_d0(o, vb0, pa0, pa1, pa2, pa3); partialSM(pB0, pB1, m_reg, mnB, alB, Cq);
  __syncthreads(); RESC(alB);
  finishSM(pB0, pB1, alB, l_reg, pa0, pa1, pa2, pa3); SBAR();
  pv_d0(o, vb0 + SHM_V, pa0, pa1, pa2, pa3);
  if (hi == 0) li_l[r32] = l_reg; asm volatile("s_waitcnt lgkmcnt(0)" ::: "memory");
  float rli[16];
#pragma unroll
  for (int r = 0; r < 16; ++r) rli[r] = __builtin_amdgcn_rcpf(li_l[crow(r, hi)]);
  __syncthreads();
  { unsigned short* stg = (unsigned short*)(lds + wid * 8192);
#pragma unroll
    for (int r = 0; r < 16; ++r) { const int orow = crow(r, hi);
#pragma unroll
      for (int d0 = 0; d0 < 4; ++d0) stg[orow * 128 + d0 * 32 + r32] = f2bf1(o[d0][r] * rli[r]); }
    asm volatile("s_waitcnt lgkmcnt(0)" ::: "memory");
    const int er = lane >> 4, ec = (lane & 15) * 8;
    const bf16* Gw = Gb + (size_t)(wid * 32 + er) * 128 + ec; bf16* Ow = Ob + (size_t)(wid * 32 + er) * KP + ec;
#pragma unroll
    for (int i = 0; i < 8; ++i) { float ov[8], gv[8]; unpack8(*(const bf16x8*)(stg + (i * 4 + er) * 128 + ec), ov); unpack8(ld8(Gw + (size_t)(i * 4) * 128), gv);
#pragma unroll
      for (int e = 0; e < 8; ++e) ov[e] *= silu_f(gv[e]);
      *(bf16x8*)(Ow + (size_t)(i * 4) * KP) = pack8(ov); asm volatile("" ::: "memory"); } }
  __syncthreads();
#undef SLOAD
#undef SWRITE
#undef SWAIT
#undef RESC
}

#define PKN(P, BASE, OUT) do { u32x4 w_ = {cvtpk(P[BASE + 0], P[BASE + 1]), cvtpk(P[BASE + 2], P[BASE + 3]), cvtpk(P[BASE + 4], P[BASE + 5]), cvtpk(P[BASE + 6], P[BASE + 7])}; OUT = *reinterpret_cast<bf16x8*>(&w_); } while (0)
__device__ __forceinline__ void finishSM_n(f32x16& p0, f32x16& p1, float alpha, float& l_reg, bf16x8& pa0, bf16x8& pa1, bf16x8& pa2, bf16x8& pa3) {
#pragma unroll
  for (int r = 0; r < 16; ++r) p1[r] = __builtin_amdgcn_exp2f(p1[r]);
  float ps = 0;
#pragma unroll
  for (int r = 0; r < 16; ++r) ps += p0[r];
#pragma unroll
  for (int r = 0; r < 16; ++r) ps += p1[r];
  { auto rr = __builtin_amdgcn_permlane32_swap(__float_as_uint(ps), __float_as_uint(ps), false, false);
    ps = __uint_as_float(rr[0]) + __uint_as_float(rr[1]); }
  l_reg = l_reg * alpha + ps;
  PKN(p0, 0, pa0); PKN(p0, 8, pa1); PKN(p1, 0, pa2); PKN(p1, 8, pa3);
}
__device__ __forceinline__ void pp_softmax_nomax(f32x16& p0, f32x16& p1, float& l_reg, bf16x8& pa0, bf16x8& pa1, bf16x8& pa2, bf16x8& pa3) {
#pragma unroll
  for (int r = 0; r < 16; ++r) p0[r] = __builtin_amdgcn_exp2f(p0[r]);
#pragma unroll
  for (int r = 0; r < 16; ++r) p1[r] = __builtin_amdgcn_exp2f(p1[r]);
  float ps = 0;
#pragma unroll
  for (int r = 0; r < 16; ++r) ps += p0[r];
#pragma unroll
  for (int r = 0; r < 16; ++r) ps += p1[r];
  { auto rr = __builtin_amdgcn_permlane32_swap(__float_as_uint(ps), __float_as_uint(ps), false, false);
    ps = __uint_as_float(rr[0]) + __uint_as_float(rr[1]); }
  l_reg += ps;
  PKN(p0, 0, pa0); PKN(p0, 8, pa1); PKN(p1, 0, pa2); PKN(p1, 8, pa3);
}
template <int OFF> __device__ __forceinline__ bf16x8 k_read(int a) { bf16x8 r; asm volatile("ds_read_b128 %0, %1 offset:%2" : "=&v"(r) : "v"(a), "i"(OFF) : "memory"); return r; }
#define PPW2(n, a, b) asm volatile("s_waitcnt lgkmcnt(" #n ")" : "+v"(a), "+v"(b) :: "memory")
#define PPW4(n, a, b, c, d) asm volatile("s_waitcnt lgkmcnt(" #n ")" : "+v"(a), "+v"(b), "+v"(c), "+v"(d) :: "memory")
template <bool HASPV, bool DUPM = false, int KS = 0  , int VS = 0  > __device__ __forceinline__ void pp_mma(f32x16& p0, f32x16& p1, f32x16* o, const bf16x8* qr, bf16x8 pa0, bf16x8 pa1, bf16x8 pa2, bf16x8 pa3, int kA0, int kA1, int kA2, int kA3, int vb) {
#define KR0(d0) k_read<((d0) >> 2) * 128 + KS>(((d0) & 3) == 0 ? kA0 : ((d0) & 3) == 1 ? kA1 : ((d0) & 3) == 2 ? kA2 : kA3)
#define KR1(d0) k_read<((d0) >> 2) * 128 + 8192 + KS>(((d0) & 3) == 0 ? kA0 : ((d0) & 3) == 1 ? kA1 : ((d0) & 3) == 2 ? kA2 : kA3)
#define HRD(u, la, ha, lb, hb) s16x4 la = tr_read<v_rd_off(2 * ((u) & 1), (u) >> 1, 0) + VS>(vb), ha = tr_read<v_rd_off(2 * ((u) & 1), (u) >> 1, 1) + VS>(vb), lb = tr_read<v_rd_off(2 * ((u) & 1) + 1, (u) >> 1, 0) + VS>(vb), hb = tr_read<v_rd_off(2 * ((u) & 1) + 1, (u) >> 1, 1) + VS>(vb)
#define KMM(d0, a, b) do { p0 = __builtin_amdgcn_mfma_f32_32x32x16_bf16(a, qr[d0], p0, 0, 0, 0); p1 = __builtin_amdgcn_mfma_f32_32x32x16_bf16(b, qr[d0], p1, 0, 0, 0); if constexpr (DUPM) { p0 = __builtin_amdgcn_mfma_f32_32x32x16_bf16(b, qr[d0], p0, 0, 0, 0); p1 = __builtin_amdgcn_mfma_f32_32x32x16_bf16(a, qr[d0], p1, 0, 0, 0); } } while (0)
#define HMM(u, pa, la, ha, lb, hb) do { o[2 * ((u) & 1)] = __builtin_amdgcn_mfma_f32_32x32x16_bf16(pa, PKV(la, ha), o[2 * ((u) & 1)], 0, 0, 0); o[2 * ((u) & 1) + 1] = __builtin_amdgcn_mfma_f32_32x32x16_bf16(pa, PKV(lb, hb), o[2 * ((u) & 1) + 1], 0, 0, 0); } while (0)
  p0 = f32x16{}; p1 = f32x16{};
  bf16x8 a0 = KR0(0), b0 = KR1(0), a1 = KR0(1), b1 = KR1(1), a2 = KR0(2), b2 = KR1(2), a3 = KR0(3), b3 = KR1(3);
  PPW2(6, a0, b0); KMM(0, a0, b0); bf16x8 a4 = KR0(4), b4 = KR1(4);
  PPW2(6, a1, b1); KMM(1, a1, b1); bf16x8 a5 = KR0(5), b5 = KR1(5);
  PPW2(6, a2, b2); KMM(2, a2, b2); bf16x8 a6 = KR0(6), b6 = KR1(6);
  PPW2(6, a3, b3); KMM(3, a3, b3); bf16x8 a7 = KR0(7), b7 = KR1(7);
  if constexpr (HASPV) {
    PPW2(6, a4, b4); KMM(4, a4, b4); HRD(0, l0a, h0a, l0b, h0b);
    PPW2(8, a5, b5); KMM(5, a5, b5); HRD(1, l1a, h1a, l1b, h1b);
    PPW2(10, a6, b6); KMM(6, a6, b6); HRD(2, l2a, h2a, l2b, h2b);
    PPW2(12, a7, b7); KMM(7, a7, b7);
    PPW4(8, l0a, h0a, l0b, h0b); HMM(0, pa0, l0a, h0a, l0b, h0b); HRD(3, l3a, h3a, l3b, h3b);
    PPW4(8, l1a, h1a, l1b, h1b); HMM(1, pa0, l1a, h1a, l1b, h1b); HRD(4, l4a, h4a, l4b, h4b);
    PPW4(8, l2a, h2a, l2b, h2b); HMM(2, pa1, l2a, h2a, l2b, h2b); HRD(5, l5a, h5a, l5b, h5b);
    PPW4(8, l3a, h3a, l3b, h3b); HMM(3, pa1, l3a, h3a, l3b, h3b); HRD(6, l6a, h6a, l6b, h6b);
    PPW4(8, l4a, h4a, l4b, h4b); HMM(4, pa2, l4a, h4a, l4b, h4b); HRD(7, l7a, h7a, l7b, h7b);
    PPW4(8, l5a, h5a, l5b, h5b); HMM(5, pa2, l5a, h5a, l5b, h5b);
    PPW4(4, l6a, h6a, l6b, h6b); HMM(6, pa3, l6a, h6a, l6b, h6b);
    PPW4(0, l7a, h7a, l7b, h7b); HMM(7, pa3, l7a, h7a, l7b, h7b);
  } else {
    PPW2(6, a4, b4); KMM(4, a4, b4);
    PPW2(4, a5, b5); KMM(5, a5, b5);
    PPW2(2, a6, b6); KMM(6, a6, b6);
    PPW2(0, a7, b7); KMM(7, a7, b7);
  }
#undef KR0
#undef KR1
#undef HRD
#undef KMM
#undef HMM
}
__device__ __forceinline__ void pp_pv_tail(f32x16* o, bf16x8 pa0, bf16x8 pa1, bf16x8 pa2, bf16x8 pa3, int vb) {
#define HRD(u, la, ha, lb, hb) s16x4 la = tr_read<v_rd_off(2 * ((u) & 1), (u) >> 1, 0)>(vb), ha = tr_read<v_rd_off(2 * ((u) & 1), (u) >> 1, 1)>(vb), lb = tr_read<v_rd_off(2 * ((u) & 1) + 1, (u) >> 1, 0)>(vb), hb = tr_read<v_rd_off(2 * ((u) & 1) + 1, (u) >> 1, 1)>(vb)
#define HMM(u, pa, la, ha, lb, hb) do { o[2 * ((u) & 1)] = __builtin_amdgcn_mfma_f32_32x32x16_bf16(pa, PKV(la, ha), o[2 * ((u) & 1)], 0, 0, 0); o[2 * ((u) & 1) + 1] = __builtin_amdgcn_mfma_f32_32x32x16_bf16(pa, PKV(lb, hb), o[2 * ((u) & 1) + 1], 0, 0, 0); } while (0)
  HRD(0, l0a, h0a, l0b, h0b); HRD(1, l1a, h1a, l1b, h1b); HRD(2, l2a, h2a, l2b, h2b);
  PPW4(8, l0a, h0a, l0b, h0b); HMM(0, pa0, l0a, h0a, l0b, h0b); HRD(3, l3a, h3a, l3b, h3b);
  PPW4(8, l1a, h1a, l1b, h1b); HMM(1, pa0, l1a, h1a, l1b, h1b); HRD(4, l4a, h4a, l4b, h4b);
  PPW4(8, l2a, h2a, l2b, h2b); HMM(2, pa1, l2a, h2a, l2b, h2b); HRD(5, l5a, h5a, l5b, h5b);
  PPW4(8, l3a, h3a, l3b, h3b); HMM(3, pa1, l3a, h3a, l3b, h3b); HRD(6, l6a, h6a, l6b, h6b);
  PPW4(8, l4a, h4a, l4b, h4b); HMM(4, pa2, l4a, h4a, l4b, h4b); HRD(7, l7a, h7a, l7b, h7b);
  PPW4(8, l5a, h5a, l5b, h5b); HMM(5, pa2, l5a, h5a, l5b, h5b);
  PPW4(4, l6a, h6a, l6b, h6b); HMM(6, pa3, l6a, h6a, l6b, h6b);
  PPW4(0, l7a, h7a, l7b, h7b); HMM(7, pa3, l7a, h7a, l7b, h7b);
#undef HRD
#undef HMM
}
template <int MODE  , bool NOMAX  > __device__ __forceinline__ void attn_unit_pp(const bf16* __restrict__ Qb, const bf16* __restrict__ Kh, const bf16* __restrict__ Vh, const bf16* __restrict__ Gb, const float* __restrict__ ssq, bf16* __restrict__ Ob, char* lds, LAS unsigned char* ldsl) {
  int tid = threadIdx.x; asm volatile("" : "+v"(tid));
  const int wid = __builtin_amdgcn_readfirstlane(tid >> 6), lane = tid & 63, r32 = lane & 31, hi = lane >> 5, role = PP_ROLE(wid);
  char* V_lds = lds; char* K_lds = lds + 3 * SHM_V;
  LAS float* ws = (LAS float*)(ldsl + 3 * SHM_V + 3 * SHM_K) + wid * 64; LAS float* li_l = ws; LAS float* al_l = ws + 32;
  unsigned koff[2], voff[2];
#pragma unroll
  for (int i = 0; i < 2; ++i) { const int blk = 2 * wid + i;
    { const int row = 4 * blk + (lane >> 4), chunk = (lane & 15) ^ (row & 7); koff[i] = (unsigned)(row * 128 + chunk * 8) * 2u; }
    { const int st = 2 * blk + (lane >> 5), k = (st >> 2) * 8 + ((lane & 31) >> 2); voff[i] = (unsigned)(k * 128 + (st & 3) * 32 + (lane & 3) * 8) * 2u; } }
#define PP_SLOT(t) (((t) - 3 * (((t) * 43) >> 7)) * SHM_V)
  const unsigned ldsb_ = (unsigned)(size_t)ldsl;
  const __amdgpu_buffer_rsrc_t srdK_ = __builtin_amdgcn_make_buffer_rsrc((void*)Kh, (short)0, SEQ * 128 * 2, 0x00020000), srdV_ = __builtin_amdgcn_make_buffer_rsrc((void*)Vh, (short)0, SEQ * 128 * 2, 0x00020000);
#define PP_DMA_K(t) do { const unsigned so_ = (unsigned)PP_SLOT(t), tb_ = (unsigned)(t) * (64u * 128u * 2u); _Pragma("unroll") for (int i_ = 0; i_ < 2; ++i_) \
    asm volatile("s_nop 4\n\ts_mov_b32 m0, %0\n\ts_nop 0\n\tbuffer_load_dwordx4 %1, %2, %3 offen lds" :: "s"(ldsb_ + 3u * SHM_V + so_ + (unsigned)(2 * wid + i_) * 1024u), "v"(koff[i_]), "s"(srdK_), "s"(tb_) : "m0", "memory"); } while (0)
#define PP_DMA_V(t) do { const unsigned so_ = (unsigned)PP_SLOT(t), tb_ = (unsigned)(t) * (64u * 128u * 2u); _Pragma("unroll") for (int i_ = 0; i_ < 2; ++i_) \
    asm volatile("s_nop 4\n\ts_mov_b32 m0, %0\n\ts_nop 0\n\tbuffer_load_dwordx4 %1, %2, %3 offen lds" :: "s"(ldsb_ + so_ + (unsigned)(2 * wid + i_) * 1024u), "v"(voff[i_]), "s"(srdV_), "s"(tb_) : "m0", "memory"); } while (0)
#define PP_ISSUE(t) do { if ((t) + 2 < NT) PP_DMA_K((t) + 2); if ((t) + 1 < NT) PP_DMA_V((t) + 1); } while (0)
#define PP_WAITL(t) do { if ((t) + 2 < NT) asm volatile("s_waitcnt vmcnt(4)" ::: "memory"); else if ((t) + 1 < NT) asm volatile("s_waitcnt vmcnt(2)" ::: "memory"); else asm volatile("s_waitcnt vmcnt(0)" ::: "memory"); } while (0)
#define PP_BAR() do { SBAR(); asm volatile("" ::: "memory"); __builtin_amdgcn_s_barrier(); asm volatile("" ::: "memory"); SBAR(); } while (0)
#define RESC(a) do { if (__any((a) < 1.f)) { if (hi == 0) al_l[r32] = (a); asm volatile("s_waitcnt lgkmcnt(0)" ::: "memory"); \
    _Pragma("unroll") for (int d = 0; d < 4; ++d) _Pragma("unroll") for (int r = 0; r < 16; ++r) o[d][r] *= al_l[crow(r, hi)]; } } while (0)
  constexpr int NT = SEQ / 64; static_assert((NT - 1) % 3 == 0, "the tile loop is unrolled by the ring period after the peeled tile 0");
  PP_DMA_K(0); PP_DMA_K(1); PP_DMA_V(0);
  float m_reg = -1e30f, l_reg = 0; f32x16 o[4] = {}; bf16x8 qr[8];
  const bf16* Qw = Qb + (size_t)(wid * 32 + r32) * 128 + hi * 8;
#pragma unroll
  for (int d0 = 0; d0 < 8; ++d0) qr[d0] = ld8(Qw + d0 * 16);
  float Cq; { const f32x4 pq = *(const f32x4*)(ssq + (size_t)(wid * 32 + r32) * 64); Cq = ATT_SCALE * 1.4426950408889634f / sqrtf(((pq.x + pq.y) + (pq.z + pq.w)) * (1.f / 128.f) + EPS); }
  const int vb0 = (int)(uintptr_t)V_lds + v_rd_base(lane);
  int kb[4];
  { const int c = ((r32 & 7) ^ hi) * 16, e = c >> 5;
#pragma unroll
    for (int k = 0; k < 4; ++k) kb[k] = (int)(uintptr_t)K_lds + r32 * 256 + (c & 16) + ((k ^ e) * 32); }
  f32x16 S0 = {}, S1 = {}; float mn, al; bf16x8 pa0 = {}, pa1 = {}, pa2 = {}, pa3 = {};
  asm volatile("s_waitcnt vmcnt(0) lgkmcnt(0)" ::: "memory");
  if constexpr (NOMAX) {
#pragma unroll
    for (int d0 = 0; d0 < 8; ++d0) qr[d0] = scale8(qr[d0], Cq); }
#pragma unroll
  for (int d0 = 0; d0 < 8; ++d0) asm volatile("" : "+v"(qr[d0]));
  asm volatile("" : "+v"(Cq));
  PP_BAR();
#define PP_SOFTMAX() do { if (MODE == 5 && role) { } else if constexpr (MODE == 0 || MODE == 2 || MODE == 5) { if constexpr (MODE == 2) { asm volatile("" : "+v"(S0), "+v"(S1)); } if constexpr (NOMAX) { pp_softmax_nomax(S0, S1, l_reg, pa0, pa1, pa2, pa3); } else { partialSM(S0, S1, m_reg, mn, al, Cq); finishSM_n(S0, S1, al, l_reg, pa0, pa1, pa2, pa3); RESC(al); } if constexpr (MODE == 2) { asm volatile("" :: "v"(pa0), "v"(pa1), "v"(pa2), "v"(pa3)); } } else { asm volatile("" :: "v"(S0), "v"(S1)); asm volatile("" : "+v"(pa0), "+v"(pa1), "+v"(pa2), "+v"(pa3)); } } while (0)
#define PP_MMA3(KSL, VSL) do { if (MODE == 5 && role) { } else if constexpr (MODE == 0 || MODE == 1 || MODE == 4 || MODE == 5) { pp_mma<true, MODE == 4, (KSL) * SHM_K, (VSL) * SHM_V>(S0, S1, o, qr, pa0, pa1, pa2, pa3, kb[0], kb[1], kb[2], kb[3], vb0); } } while (0)
  if (PP_PRIO && role) __builtin_amdgcn_s_setprio(PP_PRIO);
  if (role == 0) {
    pp_mma<false>(S0, S1, o, qr, pa0, pa1, pa2, pa3, kb[0], kb[1], kb[2], kb[3], vb0); SBAR(); PP_ISSUE(0); PP_SOFTMAX(); PP_WAITL(0); PP_BAR();
#pragma unroll 1
    for (int j = 1; j < NT; j += 3) {
      PP_MMA3(1, 0); SBAR(); PP_ISSUE(j); PP_SOFTMAX(); PP_WAITL(j); PP_BAR();
      PP_MMA3(2, 1); SBAR(); PP_ISSUE(j + 1); PP_SOFTMAX(); PP_WAITL(j + 1); PP_BAR();
      PP_MMA3(0, 2); SBAR(); PP_ISSUE(j + 2); PP_SOFTMAX(); PP_WAITL(j + 2); PP_BAR(); }
  } else {
    PP_ISSUE(0); pp_mma<false>(S0, S1, o, qr, pa0, pa1, pa2, pa3, kb[0], kb[1], kb[2], kb[3], vb0); PP_WAITL(0); PP_BAR();
#pragma unroll 1
    for (int j = 1; j < NT; j += 3) {
      PP_ISSUE(j); PP_SOFTMAX(); SBAR(); PP_MMA3(1, 0); PP_WAITL(j); PP_BAR();
      PP_ISSUE(j + 1); PP_SOFTMAX(); SBAR(); PP_MMA3(2, 1); PP_WAITL(j + 1); PP_BAR();
      PP_ISSUE(j + 2); PP_SOFTMAX(); SBAR(); PP_MMA3(0, 2); PP_WAITL(j + 2); PP_BAR(); }
    PP_SOFTMAX(); SBAR();
  }
  pp_pv_tail(o, pa0, pa1, pa2, pa3, vb0 + PP_SLOT(NT - 1));
  if (PP_PRIO && role) __builtin_amdgcn_s_setprio(0);
  const int er = lane >> 4, ec = (lane & 15) * 8;
  const bf16* Gw = Gb + (size_t)(wid * 32 + er) * 128 + ec; bf16* Ow = Ob + (size_t)(wid * 32 + er) * KP + ec;
  bf16x8 gt[8];
#pragma unroll
  for (int i = 0; i < 8; ++i) gt[i] = ld8(Gw + (size_t)(i * 4) * 128);
  if (hi == 0) li_l[r32] = l_reg; asm volatile("s_waitcnt lgkmcnt(0)" ::: "memory");
  float rli[16];
#pragma unroll
  for (int r = 0; r < 16; ++r) rli[r] = __builtin_amdgcn_rcpf(li_l[crow(r, hi)]);
  __syncthreads();
  { unsigned short* stg = (unsigned short*)(lds + wid * 8192);
#pragma unroll
    for (int r = 0; r < 16; ++r) { const int orow = crow(r, hi);
#pragma unroll
      for (int d0 = 0; d0 < 4; ++d0) stg[orow * 128 + d0 * 32 + r32] = f2bf1(o[d0][r] * rli[r]); }
    asm volatile("s_waitcnt lgkmcnt(0)" ::: "memory");
#pragma unroll
    for (int i = 0; i < 8; ++i) { float ov[8], gv[8]; unpack8(*(const bf16x8*)(stg + (i * 4 + er) * 128 + ec), ov); unpack8(gt[i], gv);
#pragma unroll
      for (int e = 0; e < 8; ++e) ov[e] *= silu_f(gv[e]);
      *(bf16x8*)(Ow + (size_t)(i * 4) * KP) = pack8(ov); } }
  asm volatile("s_waitcnt vmcnt(0)" ::: "memory");
  __syncthreads();
#undef PP_SLOT
#undef PP_SOFTMAX
#undef PP_MMA3
#undef PP_DMA_K
#undef PP_DMA_V
#undef PP_ISSUE
#undef PP_WAITL
#undef PP_BAR
#undef RESC
}

__device__ __forceinline__ s16x4 tr_read16(int vb, int off) { s16x4 r; asm volatile("ds_read_b64_tr_b16 %0, %1" : "=&v"(r) : "v"(vb + off) : "memory"); return r; }
template <bool HASPV, int KS, int VS> __device__ __forceinline__ void p16_mma(f32x4 (&S)[4][2], f32x4 (&O)[2][8], const bf16x8 (&qr)[2][4], const bf16x8 (&pa)[2][2], const int* ka  , int vb) {
#define P16_W(n) do { asm volatile("s_waitcnt lgkmcnt(" #n ")" ::: "memory"); SBAR(); } while (0)
#define P16_KMM(ds, kb, f) do { S[kb][0] = __builtin_amdgcn_mfma_f32_16x16x32_bf16(f, qr[0][ds], S[kb][0], 0, 0, 0); S[kb][1] = __builtin_amdgcn_mfma_f32_16x16x32_bf16(f, qr[1][ds], S[kb][1], 0, 0, 0); } while (0)
#define P16_VMM(s, db, lo, hi) do { const bf16x8 vf_ = PKV(lo, hi); O[0][db] = __builtin_amdgcn_mfma_f32_16x16x32_bf16(pa[s][0], vf_, O[0][db], 0, 0, 0); O[1][db] = __builtin_amdgcn_mfma_f32_16x16x32_bf16(pa[s][1], vf_, O[1][db], 0, 0, 0); } while (0)
#pragma unroll
  for (int kb = 0; kb < 4; ++kb) { S[kb][0] = (f32x4){0.f, 0.f, 0.f, 0.f}; S[kb][1] = (f32x4){0.f, 0.f, 0.f, 0.f}; }
  if constexpr (HASPV) {
    const bf16x8 kfa0 = k_read<0 + KS>(ka[0]);
    const bf16x8 kfa1 = k_read<4096 + KS>(ka[0]);
    const bf16x8 kfa2 = k_read<8192 + KS>(ka[0]);
    const bf16x8 kfa3 = k_read<12288 + KS>(ka[0]);
    const bf16x8 kfa4 = k_read<0 + KS>(ka[1]);
    const bf16x8 kfa5 = k_read<4096 + KS>(ka[1]);
    P16_W(5);
    P16_KMM(0, 0, kfa0);
    const bf16x8 kfa6 = k_read<8192 + KS>(ka[1]);
    P16_W(5);
    P16_KMM(0, 1, kfa1);
    const bf16x8 kfa7 = k_read<12288 + KS>(ka[1]);
    P16_W(5);
    P16_KMM(0, 2, kfa2);
    const bf16x8 kfa8 = k_read<0 + KS>(ka[2]);
    P16_W(5);
    P16_KMM(0, 3, kfa3);
    const bf16x8 kfa9 = k_read<4096 + KS>(ka[2]);
    P16_W(5);
    P16_KMM(1, 0, kfa4);
    const bf16x8 kfa10 = k_read<8192 + KS>(ka[2]);
    P16_W(5);
    P16_KMM(1, 1, kfa5);
    const bf16x8 kfa11 = k_read<12288 + KS>(ka[2]);
    P16_W(5);
    P16_KMM(1, 2, kfa6);
    const bf16x8 kfa12 = k_read<0 + KS>(ka[3]);
    P16_W(5);
    P16_KMM(1, 3, kfa7);
    const bf16x8 kfa13 = k_read<4096 + KS>(ka[3]);
    P16_W(5);
    P16_KMM(2, 0, kfa8);
    const bf16x8 kfa14 = k_read<8192 + KS>(ka[3]);
    P16_W(5);
    P16_KMM(2, 1, kfa9);
    const bf16x8 kfa15 = k_read<12288 + KS>(ka[3]);
    P16_W(5);
    P16_KMM(2, 2, kfa10);
    const s16x4 vla16 = tr_read<0 + VS>(vb), vha16 = tr_read<4096 + VS>(vb);
    P16_W(6);
    P16_KMM(2, 3, kfa11);
    const s16x4 vla17 = tr_read<256 + VS>(vb), vha17 = tr_read<4352 + VS>(vb);
    P16_W(7);
    P16_KMM(3, 0, kfa12);
    const s16x4 vla18 = tr_read<512 + VS>(vb), vha18 = tr_read<4608 + VS>(vb);
    P16_W(8);
    P16_KMM(3, 1, kfa13);
    const s16x4 vla19 = tr_read<768 + VS>(vb), vha19 = tr_read<4864 + VS>(vb);
    P16_W(9);
    P16_KMM(3, 2, kfa14);
    const s16x4 vla20 = tr_read<1024 + VS>(vb), vha20 = tr_read<5120 + VS>(vb);
    P16_W(10);
    P16_KMM(3, 3, kfa15);
    const s16x4 vla21 = tr_read<1280 + VS>(vb), vha21 = tr_read<5376 + VS>(vb);
    P16_W(10);
    P16_VMM(0, 0, vla16, vha16);
    const s16x4 vla22 = tr_read<1536 + VS>(vb), vha22 = tr_read<5632 + VS>(vb);
    P16_W(10);
    P16_VMM(0, 1, vla17, vha17);
    const s16x4 vla23 = tr_read<1792 + VS>(vb), vha23 = tr_read<5888 + VS>(vb);
    P16_W(10);
    P16_VMM(0, 2, vla18, vha18);
    const s16x4 vla24 = tr_read<8192 + VS>(vb), vha24 = tr_read<12288 + VS>(vb);
    P16_W(10);
    P16_VMM(0, 3, vla19, vha19);
    const s16x4 vla25 = tr_read<8448 + VS>(vb), vha25 = tr_read<12544 + VS>(vb);
    P16_W(10);
    P16_VMM(0, 4, vla20, vha20);
    const s16x4 vla26 = tr_read<8704 + VS>(vb), vha26 = tr_read<12800 + VS>(vb);
    P16_W(10);
    P16_VMM(0, 5, vla21, vha21);
    const s16x4 vla27 = tr_read<8960 + VS>(vb), vha27 = tr_read<13056 + VS>(vb);
    P16_W(10);
    P16_VMM(0, 6, vla22, vha22);
    const s16x4 vla28 = tr_read<9216 + VS>(vb), vha28 = tr_read<13312 + VS>(vb);
    P16_W(10);
    P16_VMM(0, 7, vla23, vha23);
    const s16x4 vla29 = tr_read<9472 + VS>(vb), vha29 = tr_read<13568 + VS>(vb);
    P16_W(10);
    P16_VMM(1, 0, vla24, vha24);
    const s16x4 vla30 = tr_read<9728 + VS>(vb), vha30 = tr_read<13824 + VS>(vb);
    P16_W(10);
    P16_VMM(1, 1, vla25, vha25);
    const s16x4 vla31 = tr_read<9984 + VS>(vb), vha31 = tr_read<14080 + VS>(vb);
    P16_W(10);
    P16_VMM(1, 2, vla26, vha26);
    P16_W(8);
    P16_VMM(1, 3, vla27, vha27);
    P16_W(6);
    P16_VMM(1, 4, vla28, vha28);
    P16_W(4);
    P16_VMM(1, 5, vla29, vha29);
    P16_W(2);
    P16_VMM(1, 6, vla30, vha30);
    P16_W(0);
    P16_VMM(1, 7, vla31, vha31);
  } else {
    const bf16x8 kfb0 = k_read<0 + KS>(ka[0]);
    const bf16x8 kfb1 = k_read<4096 + KS>(ka[0]);
    const bf16x8 kfb2 = k_read<8192 + KS>(ka[0]);
    const bf16x8 kfb3 = k_read<12288 + KS>(ka[0]);
    const bf16x8 kfb4 = k_read<0 + KS>(ka[1]);
    const bf16x8 kfb5 = k_read<4096 + KS>(ka[1]);
    P16_W(5);
    P16_KMM(0, 0, kfb0);
    const bf16x8 kfb6 = k_read<8192 + KS>(ka[1]);
    P16_W(5);
    P16_KMM(0, 1, kfb1);
    const bf16x8 kfb7 = k_read<12288 + KS>(ka[1]);
    P16_W(5);
    P16_KMM(0, 2, kfb2);
    const bf16x8 kfb8 = k_read<0 + KS>(ka[2]);
    P16_W(5);
    P16_KMM(0, 3, kfb3);
    const bf16x8 kfb9 = k_read<4096 + KS>(ka[2]);
    P16_W(5);
    P16_KMM(1, 0, kfb4);
    const bf16x8 kfb10 = k_read<8192 + KS>(ka[2]);
    P16_W(5);
    P16_KMM(1, 1, kfb5);
    const bf16x8 kfb11 = k_read<12288 + KS>(ka[2]);
    P16_W(5);
    P16_KMM(1, 2, kfb6);
    const bf16x8 kfb12 = k_read<0 + KS>(ka[3]);
    P16_W(5);
    P16_KMM(1, 3, kfb7);
    const bf16x8 kfb13 = k_read<4096 + KS>(ka[3]);
    P16_W(5);
    P16_KMM(2, 0, kfb8);
    const bf16x8 kfb14 = k_read<8192 + KS>(ka[3]);
    P16_W(5);
    P16_KMM(2, 1, kfb9);
    const bf16x8 kfb15 = k_read<12288 + KS>(ka[3]);
    P16_W(5);
    P16_KMM(2, 2, kfb10);
    P16_W(4);
    P16_KMM(2, 3, kfb11);
    P16_W(3);
    P16_KMM(3, 0, kfb12);
    P16_W(2);
    P16_KMM(3, 1, kfb13);
    P16_W(1);
    P16_KMM(3, 2, kfb14);
    P16_W(0);
    P16_KMM(3, 3, kfb15);
  }
#undef P16_W
#undef P16_KMM
#undef P16_VMM
}
__device__ __forceinline__ void p16_pv_tail(f32x4 (&O)[2][8], const bf16x8 (&pa)[2][2], int vb) {
#define P16_W(n) do { asm volatile("s_waitcnt lgkmcnt(" #n ")" ::: "memory"); SBAR(); } while (0)
#define P16_VMM(s, db, lo, hi) do { const bf16x8 vf_ = PKV(lo, hi); O[0][db] = __builtin_amdgcn_mfma_f32_16x16x32_bf16(pa[s][0], vf_, O[0][db], 0, 0, 0); O[1][db] = __builtin_amdgcn_mfma_f32_16x16x32_bf16(pa[s][1], vf_, O[1][db], 0, 0, 0); } while (0)
  const s16x4 vlt0 = tr_read<0>(vb), vht0 = tr_read<4096>(vb);
  const s16x4 vlt1 = tr_read<256>(vb), vht1 = tr_read<4352>(vb);
  const s16x4 vlt2 = tr_read<512>(vb), vht2 = tr_read<4608>(vb);
  const s16x4 vlt3 = tr_read<768>(vb), vht3 = tr_read<4864>(vb);
  const s16x4 vlt4 = tr_read<1024>(vb), vht4 = tr_read<5120>(vb);
  const s16x4 vlt5 = tr_read<1280>(vb), vht5 = tr_read<5376>(vb);
  P16_W(10);
  P16_VMM(0, 0, vlt0, vht0);
  const s16x4 vlt6 = tr_read<1536>(vb), vht6 = tr_read<5632>(vb);
  P16_W(10);
  P16_VMM(0, 1, vlt1, vht1);
  const s16x4 vlt7 = tr_read<1792>(vb), vht7 = tr_read<5888>(vb);
  P16_W(10);
  P16_VMM(0, 2, vlt2, vht2);
  const s16x4 vlt8 = tr_read<8192>(vb), vht8 = tr_read<12288>(vb);
  P16_W(10);
  P16_VMM(0, 3, vlt3, vht3);
  const s16x4 vlt9 = tr_read<8448>(vb), vht9 = tr_read<12544>(vb);
  P16_W(10);
  P16_VMM(0, 4, vlt4, vht4);
  const s16x4 vlt10 = tr_read<8704>(vb), vht10 = tr_read<12800>(vb);
  P16_W(10);
  P16_VMM(0, 5, vlt5, vht5);
  const s16x4 vlt11 = tr_read<8960>(vb), vht11 = tr_read<13056>(vb);
  P16_W(10);
  P16_VMM(0, 6, vlt6, vht6);
  const s16x4 vlt12 = tr_read<9216>(vb), vht12 = tr_read<13312>(vb);
  P16_W(10);
  P16_VMM(0, 7, vlt7, vht7);
  const s16x4 vlt13 = tr_read<9472>(vb), vht13 = tr_read<13568>(vb);
  P16_W(10);
  P16_VMM(1, 0, vlt8, vht8);
  const s16x4 vlt14 = tr_read<9728>(vb), vht14 = tr_read<13824>(vb);
  P16_W(10);
  P16_VMM(1, 1, vlt9, vht9);
  const s16x4 vlt15 = tr_read<9984>(vb), vht15 = tr_read<14080>(vb);
  P16_W(10);
  P16_VMM(1, 2, vlt10, vht10);
  P16_W(8);
  P16_VMM(1, 3, vlt11, vht11);
  P16_W(6);
  P16_VMM(1, 4, vlt12, vht12);
  P16_W(4);
  P16_VMM(1, 5, vlt13, vht13);
  P16_W(2);
  P16_VMM(1, 6, vlt14, vht14);
  P16_W(0);
  P16_VMM(1, 7, vlt15, vht15);
#undef P16_W
#undef P16_VMM
}
__device__ __forceinline__ void p16_softmax(f32x4 (&S)[4][2], float (&lsum)[2], bf16x8 (&pa)[2][2]) {
#pragma unroll
  for (int qb = 0; qb < 2; ++qb) { float ps = 0.f;
#pragma unroll
    for (int s = 0; s < 2; ++s) {
      float e[8];
#pragma unroll
      for (int i = 0; i < 8; ++i) { e[i] = __builtin_amdgcn_exp2f(S[2 * s + (i >> 2)][qb][i & 3]); ps += e[i]; }
      u32x4 w_ = {cvtpk(e[0], e[1]), cvtpk(e[2], e[3]), cvtpk(e[4], e[5]), cvtpk(e[6], e[7])};
      pa[s][qb] = *reinterpret_cast<bf16x8*>(&w_);
      asm volatile("" : "+v"(ps));
      SBAR(); }
    lsum[qb] += ps; asm volatile("" : "+v"(lsum[qb])); }
}
__device__ __forceinline__ void attn_unit_p16(const bf16* __restrict__ Qb, const bf16* __restrict__ Kh, const bf16* __restrict__ Vh, const bf16* __restrict__ Gb, const float* __restrict__ ssq, bf16* __restrict__ Ob, char* lds, LAS unsigned char* ldsl) {
  int tid = threadIdx.x; asm volatile("" : "+v"(tid));
  const int wid = __builtin_amdgcn_readfirstlane(tid >> 6), lane = tid & 63, c16 = lane & 15, g = lane >> 4, role = wid >> 2;
  char* V_lds = lds; char* K_lds = lds + 3 * SHM_V;
  LAS float* li_l = (LAS float*)(ldsl + 3 * SHM_V + 3 * SHM_K) + wid * 64;
  unsigned koff[2], voff[2];
#pragma unroll
  for (int i = 0; i < 2; ++i) { const int blk = 2 * wid + i;
    { const int row = 4 * blk + (lane >> 4), chunk = (lane & 15) ^ (row & 15); koff[i] = (unsigned)(row * 128 + chunk * 8) * 2u; }
    { const int p = blk * 64 + lane, id = p >> 4, rho = (p & 15) >> 1, hh = p & 1, key = 8 * (id >> 3) + rho, d = 16 * (id & 7) + 8 * hh; voff[i] = (unsigned)(key * 128 + d) * 2u; } }
#define PP_SLOT(t) (((t) - 3 * (((t) * 43) >> 7)) * SHM_V)
  const unsigned ldsb_ = (unsigned)(size_t)ldsl;
  const __amdgpu_buffer_rsrc_t srdK_ = __builtin_amdgcn_make_buffer_rsrc((void*)Kh, (short)0, SEQ * 128 * 2, 0x00020000), srdV_ = __builtin_amdgcn_make_buffer_rsrc((void*)Vh, (short)0, SEQ * 128 * 2, 0x00020000);
#define PP_DMA_K(t) do { const unsigned so_ = (unsigned)PP_SLOT(t), tb_ = (unsigned)(t) * (64u * 128u * 2u); _Pragma("unroll") for (int i_ = 0; i_ < 2; ++i_) \
    asm volatile("s_nop 4\n\ts_mov_b32 m0, %0\n\ts_nop 0\n\tbuffer_load_dwordx4 %1, %2, %3 offen lds" :: "s"(ldsb_ + 3u * SHM_V + so_ + (unsigned)(2 * wid + i_) * 1024u), "v"(koff[i_]), "s"(srdK_), "s"(tb_) : "m0", "memory"); } while (0)
#define PP_DMA_V(t) do { const unsigned so_ = (unsigned)PP_SLOT(t), tb_ = (unsigned)(t) * (64u * 128u * 2u); _Pragma("unroll") for (int i_ = 0; i_ < 2; ++i_) \
    asm volatile("s_nop 4\n\ts_mov_b32 m0, %0\n\ts_nop 0\n\tbuffer_load_dwordx4 %1, %2, %3 offen lds" :: "s"(ldsb_ + so_ + (unsigned)(2 * wid + i_) * 1024u), "v"(voff[i_]), "s"(srdV_), "s"(tb_) : "m0", "memory"); } while (0)
#define PP_ISSUE(t) do { if ((t) + 2 < NT) PP_DMA_K((t) + 2); if ((t) + 1 < NT) PP_DMA_V((t) + 1); } while (0)
#define PP_WAITL(t) do { if ((t) + 2 < NT) asm volatile("s_waitcnt vmcnt(4)" ::: "memory"); else if ((t) + 1 < NT) asm volatile("s_waitcnt vmcnt(2)" ::: "memory"); else asm volatile("s_waitcnt vmcnt(0)" ::: "memory"); } while (0)
#define PP_BAR() do { SBAR(); asm volatile("" ::: "memory"); __builtin_amdgcn_s_barrier(); asm volatile("" ::: "memory"); SBAR(); } while (0)
  constexpr int NT = SEQ / 64; static_assert((NT - 1) % 3 == 0, "tile loop unrolled by the ring period");
  PP_DMA_K(0); PP_DMA_K(1); PP_DMA_V(0);
  f32x4 O[2][8]; bf16x8 qr[2][4]; float lsum[2] = {0.f, 0.f};
#pragma unroll
  for (int qb = 0; qb < 2; ++qb)
#pragma unroll
    for (int db = 0; db < 8; ++db) O[qb][db] = (f32x4){0.f, 0.f, 0.f, 0.f};
#pragma unroll
  for (int qb = 0; qb < 2; ++qb) { const bf16* Qw = Qb + (size_t)(wid * 32 + 16 * qb + c16) * 128 + 8 * g;
#pragma unroll
    for (int ds = 0; ds < 4; ++ds) qr[qb][ds] = ld8(Qw + 32 * ds); }
  float Cq[2];
#pragma unroll
  for (int qb = 0; qb < 2; ++qb) { const f32x4 pq = *(const f32x4*)(ssq + (size_t)(wid * 32 + 16 * qb + c16) * 64); Cq[qb] = ATT_SCALE * 1.4426950408889634f / sqrtf(((pq.x + pq.y) + (pq.z + pq.w)) * (1.f / 128.f) + EPS); }
  int ka[4];
#pragma unroll
  for (int ds = 0; ds < 4; ++ds) ka[ds] = (int)(uintptr_t)K_lds + c16 * 256 + (((4 * ds + g) ^ c16) << 4);
  const int vb0 = (int)(uintptr_t)V_lds + ((g >> 1) * 8) * 256 + (4 * (g & 1) + ((lane & 15) >> 2)) * 32 + (lane & 3) * 8;
  f32x4 S[4][2]; bf16x8 pa[2][2];
  asm volatile("s_waitcnt vmcnt(0) lgkmcnt(0)" ::: "memory");
#pragma unroll
  for (int qb = 0; qb < 2; ++qb)
#pragma unroll
    for (int ds = 0; ds < 4; ++ds) { qr[qb][ds] = scale8(qr[qb][ds], Cq[qb]); asm volatile("" : "+v"(qr[qb][ds])); }
  PP_BAR();
#define P16_MMA3(KSL, VSL) p16_mma<true, (KSL) * SHM_K, (VSL) * SHM_V>(S, O, qr, pa, ka, vb0)
  if (role == 0) {
    p16_mma<false, 0, 0>(S, O, qr, pa, ka, vb0); SBAR(); PP_ISSUE(0); p16_softmax(S, lsum, pa); PP_WAITL(0); PP_BAR();
#pragma unroll 1
    for (int j = 1; j < NT; j += 3) {
      P16_MMA3(1, 0); SBAR(); PP_ISSUE(j); p16_softmax(S, lsum, pa); PP_WAITL(j); PP_BAR();
      P16_MMA3(2, 1); SBAR(); PP_ISSUE(j + 1); p16_softmax(S, lsum, pa); PP_WAITL(j + 1); PP_BAR();
      P16_MMA3(0, 2); SBAR(); PP_ISSUE(j + 2); p16_softmax(S, lsum, pa); PP_WAITL(j + 2); PP_BAR(); }
  } else {
    PP_ISSUE(0); p16_mma<false, 0, 0>(S, O, qr, pa, ka, vb0); PP_WAITL(0); PP_BAR();
#pragma unroll 1
    for (int j = 1; j < NT; j += 3) {
      PP_ISSUE(j); p16_softmax(S, lsum, pa); SBAR(); P16_MMA3(1, 0); PP_WAITL(j); PP_BAR();
      PP_ISSUE(j + 1); p16_softmax(S, lsum, pa); SBAR(); P16_MMA3(2, 1); PP_WAITL(j + 1); PP_BAR();
      PP_ISSUE(j + 2); p16_softmax(S, lsum, pa); SBAR(); P16_MMA3(0, 2); PP_WAITL(j + 2); PP_BAR(); }
    p16_softmax(S, lsum, pa); SBAR();
  }
  p16_pv_tail(O, pa, vb0 + PP_SLOT(NT - 1));
  int te_ = threadIdx.x; asm volatile("" : "+v"(te_));
  const int le = te_ & 63, ce = le & 15, ge = le >> 4;
  LAS float* li_e = (LAS float*)(ldsl + 3 * SHM_V + 3 * SHM_K) + wid * 64;
  float rli[2][4];
#pragma unroll
  for (int qb = 0; qb < 2; ++qb) { const float lt = pg8::row4_sum(lsum[qb]); if (ge == 0) li_e[16 * qb + ce] = lt; }
  asm volatile("s_waitcnt lgkmcnt(0)" ::: "memory");
#pragma unroll
  for (int qb = 0; qb < 2; ++qb)
#pragma unroll
    for (int r = 0; r < 4; ++r) rli[qb][r] = __builtin_amdgcn_rcpf(li_e[16 * qb + 4 * ge + r]);
  __syncthreads();
  { LAS unsigned short* stg = (LAS unsigned short*)(ldsl + wid * 8192);
#pragma unroll
    for (int qb = 0; qb < 2; ++qb)
#pragma unroll
      for (int db = 0; db < 8; ++db)
#pragma unroll
        for (int r = 0; r < 4; ++r) stg[(16 * qb + 4 * ge + r) * 128 + 16 * db + ce] = f2bf1(O[qb][db][r] * rli[qb][r]);
    asm volatile("s_waitcnt lgkmcnt(0)" ::: "memory");
    const int er = le >> 4, ec = (le & 15) * 8;
    const bf16* Gw = Gb + (size_t)(wid * 32 + er) * 128 + ec; bf16* Ow = Ob + (size_t)(wid * 32 + er) * KP + ec;
#pragma unroll
    for (int i = 0; i < 8; ++i) { float ov[8], gv[8]; unpack8(*(const LAS bf16x8*)(stg + (i * 4 + er) * 128 + ec), ov); unpack8(ld8(Gw + (size_t)(i * 4) * 128), gv);
#pragma unroll
      for (int e = 0; e < 8; ++e) ov[e] *= silu_f(gv[e]);
      *(bf16x8*)(Ow + (size_t)(i * 4) * KP) = pack8(ov); asm volatile("" ::: "memory"); } }
  asm volatile("s_waitcnt vmcnt(0)" ::: "memory");
  __syncthreads();
#undef PP_SLOT
#undef PP_DMA_K
#undef PP_DMA_V
#undef PP_ISSUE
#undef PP_WAITL
#undef PP_BAR
#undef P16_MMA3
}

__device__ __forceinline__ s16x4 tr_read_rt(int addr) { s16x4 r; asm volatile("ds_read_b64_tr_b16 %0, %1" : "=&v"(r) : "v"(addr) : "memory"); return r; }
__device__ __forceinline__ void scan_unit(int b, int h, int dir, int es, const bf16* __restrict__ RV, const bf16* __restrict__ RKC, bf16* __restrict__ FST, float lg2, char* lds) {
  int tid = threadIdx.x; asm volatile("" : "+v"(tid));
  const int wid = tid >> 6, lane = tid & 63, r32 = lane & 31, hi = lane >> 5, db = wid & 3, eb = wid >> 2;
  char* Kl = lds; char* Vl = lds + 32768;
  const int vbK = (int)(uintptr_t)Kl + v_rd_base(lane) + db * 512, vbV = (int)(uintptr_t)Vl + v_rd_base(lane) + eb * 512;
  const float gC = __builtin_amdgcn_exp2f(lg2 * 128.f);
  const int sr = tid >> 4, sc = (tid & 15) * 8;
  const bf16* Kg = RKC + (size_t)(b * RH + h) * SEQ * 128;
  const bf16* Vg = RV + (size_t)(b * RH + h) * SEQ * 256 + es * 64;
  bf16* Fbase = FST + ((((size_t)dir * BATCH + b) * RH + h) * NCH) * 32768 + es * 64 + eb * 32 + r32;
  f32x16 acc = {};
  bf16x8 kA[4], vA[2], kB[4], vB[2], kC[4], vC[2];
#define SC_LOAD(KR, VR, j) do { const size_t rb_ = (size_t)(j) * 128; \
    _Pragma("unroll") for (int q_ = 0; q_ < 4; ++q_) KR[q_] = ld8(Kg + (rb_ + (q_ >> 1) * 64 + sr + 32 * (q_ & 1)) * 128 + sc); \
    _Pragma("unroll") for (int i_ = 0; i_ < 2; ++i_) { const int p_ = tid + 512 * i_; VR[i_] = ld8(Vg + (rb_ + (p_ >> 3)) * 256 + (p_ & 7) * 8); } } while (0)
#define SC_WRITE(KR, VR) do { \
    _Pragma("unroll") for (int q_ = 0; q_ < 4; ++q_) { const int row_ = sr + 32 * (q_ & 1), m_ = (q_ >> 1) * 64 + row_; \
        const float z_ = __builtin_amdgcn_exp2f(lg2 * (float)(dir ? m_ : 127 - m_)); *(bf16x8*)(Kl + (q_ >> 1) * 16384 + v_st(row_, sc)) = scale8(KR[q_], z_); } \
    _Pragma("unroll") for (int i_ = 0; i_ < 2; ++i_) { const int p_ = tid + 512 * i_, m_ = p_ >> 3; *(bf16x8*)(Vl + (m_ >> 6) * 16384 + v_st(m_ & 63, (p_ & 7) * 8)) = VR[i_]; } } while (0)
#define SC_CHUNK(s) (dir ? NCH - 1 - (s) : (s))
  unsigned short* Stg = (unsigned short*)(lds + 65536); bf16* Fslice = FST + ((((size_t)dir * BATCH + b) * RH + h) * NCH) * 32768 + es * 64;
#define SC_STAGE() do { _Pragma("unroll") for (int r = 0; r < 16; ++r) Stg[(db * 32 + crow(r, hi)) * 64 + eb * 32 + r32] = f2bf1(acc[r]); } while (0)
#define SC_FLUSH(j) do { _Pragma("unroll") for (int i_ = 0; i_ < 2; ++i_) { const int q_ = tid + 512 * i_, d_ = q_ >> 3, ec_ = (q_ & 7) * 8; \
    *(bf16x8*)(Fslice + (size_t)(j) * 32768 + d_ * 256 + ec_) = *(const bf16x8*)(Stg + d_ * 64 + ec_); } } while (0)
#define SC_STEP(KR, VR, s) do { \
    SC_STAGE(); __syncthreads(); SC_WRITE(KR, VR); SC_FLUSH(SC_CHUNK(s)); __syncthreads(); \
    if ((s) + 3 < NCH - 1) SC_LOAD(KR, VR, SC_CHUNK((s) + 3)); \
    _Pragma("unroll") for (int r = 0; r < 16; ++r) acc[r] *= gC; \
    _Pragma("unroll") for (int kt = 0; kt < 2; ++kt) _Pragma("unroll") for (int ks = 0; ks < 4; ++ks) { \
        const s16x4 al = tr_read_rt(vbK + kt * 16384 + v_rd_off(0, ks, 0)), ah = tr_read_rt(vbK + kt * 16384 + v_rd_off(0, ks, 1)); \
        const s16x4 bl = tr_read_rt(vbV + kt * 16384 + v_rd_off(0, ks, 0)), bh = tr_read_rt(vbV + kt * 16384 + v_rd_off(0, ks, 1)); \
        asm volatile("s_waitcnt lgkmcnt(0)" ::: "memory"); SBAR(); \
        acc = __builtin_amdgcn_mfma_f32_32x32x16_bf16(PKV(al, ah), PKV(bl, bh), acc, 0, 0, 0); } } while (0)
  SC_LOAD(kA, vA, SC_CHUNK(0)); SC_LOAD(kB, vB, SC_CHUNK(1)); SC_LOAD(kC, vC, SC_CHUNK(2));
  for (int s0 = 0; s0 < NCH - 2; s0 += 3) {
    SC_STEP(kA, vA, s0); SC_STEP(kB, vB, s0 + 1); SC_STEP(kC, vC, s0 + 2);
  }
  SC_STEP(kA, vA, NCH - 2);
  SC_STAGE(); __syncthreads(); SC_FLUSH(SC_CHUNK(NCH - 1));
  __syncthreads();
#undef SC_STAGE
#undef SC_FLUSH
#undef SC_STEP
#undef SC_CHUNK
#undef SC_LOAD
#undef SC_WRITE
}

__device__ __forceinline__ void ret_out_unit(int b, int h, int j, const bf16* __restrict__ RV, const bf16* __restrict__ GR, const bf16* __restrict__ RQC, const bf16* __restrict__ RKC, const bf16* __restrict__ FST, bf16* __restrict__ MIX, const float* __restrict__ gn, float lgf2, float lgb2, char* lds) {
  int tid = threadIdx.x; asm volatile("" : "+v"(tid));
  const int wid = tid >> 6, lane = tid & 63, r32 = lane & 31, hi = lane >> 5, qw = wid & 3, ch = wid >> 2;
  char* Kl = lds; char* Vb = lds + 32768; float* ssx = (float*)(lds + 98304);
  const size_t row0 = (size_t)b * SEQ + (size_t)j * 128;
  const int nq = qw * 32 + r32;
  const size_t hrow0 = ((size_t)(b * RH + h) * SEQ + (size_t)j * 128) * 128;
  const bf16* Qw = RQC + hrow0 + (size_t)nq * 128 + hi * 8;
  bf16x8 qr[8];
#pragma unroll
  for (int d0 = 0; d0 < 8; ++d0) qr[d0] = ld8(Qw + d0 * 16);
  const int sr = tid >> 4, sc = (tid & 15) * 8;
  const bf16* Kg = RKC + hrow0;
  const bf16* Vg = RV + ((size_t)(b * RH + h) * SEQ + (size_t)j * 128) * 256;
  const bf16* Fg = FST + ((((size_t)0 * BATCH + b) * RH + h) * NCH + j) * 32768;
  const bf16* Gg = FST + ((((size_t)1 * BATCH + b) * RH + h) * NCH + j) * 32768;
  const int vb0 = (int)(uintptr_t)Vb + v_rd_base(lane) + ch * 16384;
  bf16x8 vsA[4], vsB[4];
#define VT_LOAD(VS, t) do { const bf16* s_ = (t) < 2 ? Vg + (size_t)((t) * 64) * 256 : ((t) < 4 ? Fg + ((t) - 2) * 64 * 256 : Gg + ((t) - 4) * 64 * 256); const size_t ld_ = (size_t)256; \
    _Pragma("unroll") for (int q_ = 0; q_ < 4; ++q_) VS[q_] = ld8(s_ + (size_t)(sr + 32 * (q_ & 1)) * ld_ + (q_ >> 1) * 128 + sc); } while (0)
#define VT_WRITE(VS, bf) do { _Pragma("unroll") for (int q_ = 0; q_ < 4; ++q_) *(bf16x8*)(Vb + (bf) * 32768 + (q_ >> 1) * 16384 + v_st(sr + 32 * (q_ & 1), sc)) = VS[q_]; } while (0)
  { bf16x8 kst[4];
#pragma unroll
    for (int q_ = 0; q_ < 4; ++q_) kst[q_] = ld8(Kg + (size_t)((q_ >> 1) * 64 + sr + 32 * (q_ & 1)) * 128 + sc);
    VT_LOAD(vsB, 0);
#pragma unroll
    for (int q_ = 0; q_ < 4; ++q_) *(bf16x8*)(Kl + (q_ >> 1) * 16384 + KSWZ(sr + 32 * (q_ & 1), sc * 2)) = kst[q_];
    VT_WRITE(vsB, 0); }
  VT_LOAD(vsA, 1); VT_LOAD(vsB, 2);
  __syncthreads();
  f32x16 o[4] = {};
  bf16x8 pa0, pa1, pa2, pa3;
  float fnq = (float)(nq - 4 * hi); asm volatile("" : "+v"(fnq));
  const float nlgb2 = -lgb2;
#define VT_ADVANCE(t) do { if ((t) < 5) { if (((t) & 1) == 0) { VT_WRITE(vsA, ((t) + 1) & 1); } else { VT_WRITE(vsB, ((t) + 1) & 1); } __syncthreads(); \
    if ((t) + 3 < 6) { if (((t) & 1) == 0) { VT_LOAD(vsA, (t) + 3); } else { VT_LOAD(vsB, (t) + 3); } } } } while (0)
#pragma unroll
  for (int t = 0; t < 2; ++t) {
    f32x16 p0, p1;
    qkt(p0, p1, Kl + t * 16384, qr, r32, hi);
#pragma unroll
    for (int r = 0; r < 16; ++r) {
      const float df0 = fnq - (float)(t * 64 + (r & 3) + 8 * (r >> 2)), df1 = df0 - 32.f;
      p0[r] *= __builtin_amdgcn_exp2f(fminf(lgf2 * df0, nlgb2 * df0));
      p1[r] *= __builtin_amdgcn_exp2f(fminf(lgf2 * df1, nlgb2 * df1));
    }
    PK4(p0, 0, pa0); PK4(p0, 8, pa1); PK4(p1, 0, pa2); PK4(p1, 8, pa3);
    SBAR();
    pv_d0(o, vb0 + (t & 1) * 32768, pa0, pa1, pa2, pa3);
    VT_ADVANCE(t);
  }
  const float xif = __builtin_amdgcn_exp2f(lgf2 * (float)(nq + 1)), xib = __builtin_amdgcn_exp2f(lgb2 * (float)(128 - nq));
#pragma unroll
  for (int t = 2; t < 6; ++t) {
    const float xs = t < 4 ? xif : xib; const int dt = t & 1;
    pa0 = scale8(qr[4 * dt + 0], xs); pa1 = scale8(qr[4 * dt + 1], xs); pa2 = scale8(qr[4 * dt + 2], xs); pa3 = scale8(qr[4 * dt + 3], xs);
    SBAR();
    pv_d0(o, vb0 + (t & 1) * 32768, pa0, pa1, pa2, pa3);
    VT_ADVANCE(t);
  }
#undef VT_ADVANCE
  float ssq[16];
#pragma unroll
  for (int r = 0; r < 16; ++r) { float s = o[0][r] * o[0][r] + o[1][r] * o[1][r] + o[2][r] * o[2][r] + o[3][r] * o[3][r];
    ssq[r] = xsum32(s); }
  if (r32 == 0) {
#pragma unroll
    for (int r = 0; r < 16; ++r) ssx[(qw * 32 + crow(r, hi)) * 2 + ch] = ssq[r];
  }
  __syncthreads();
  { unsigned short* stg = (unsigned short*)(lds + wid * 8192);
    float gcol[4];
#pragma unroll
    for (int d0 = 0; d0 < 4; ++d0) gcol[d0] = gn[ch * 128 + d0 * 32 + r32];
#pragma unroll
    for (int r = 0; r < 16; ++r) { const int row = qw * 32 + crow(r, hi); const float rstd = 1.0f / sqrtf((ssx[row * 2] + ssx[row * 2 + 1]) * (1.f / 256.f) + EPS);
#pragma unroll
      for (int d0 = 0; d0 < 4; ++d0) stg[crow(r, hi) * 128 + d0 * 32 + r32] = f2bf1(o[d0][r] * rstd * gcol[d0]); }
    asm volatile("s_waitcnt lgkmcnt(0)" ::: "memory");
    const int er = lane >> 4, ec = (lane & 15) * 8;
    const bf16* Gw = GR + ((size_t)(b * RH + h) * SEQ + (size_t)j * 128 + qw * 32 + er) * 256 + ch * 128 + ec; bf16* Ow = MIX + (row0 + qw * 32 + er) * KP + 2048 + h * 256 + ch * 128 + ec;
#pragma unroll
    for (int i = 0; i < 8; ++i) { float ov[8], gv[8]; unpack8(*(const bf16x8*)(stg + (i * 4 + er) * 128 + ec), ov); unpack8(ld8(Gw + (size_t)(i * 4) * 256), gv);
#pragma unroll
      for (int e = 0; e < 8; ++e) ov[e] *= silu_f(gv[e]);
      *(bf16x8*)(Ow + (size_t)(i * 4) * KP) = pack8(ov); asm volatile("" ::: "memory"); } }
  __syncthreads();
#undef VT_LOAD
#undef VT_WRITE
}

struct Frame {
    LAS unsigned char* lds;
    volatile LAS unsigned* MISC;
    gu32* ctl;
    int tid, lane, wave;
    int vcu, G;
};

__device__ __forceinline__ int rope_perm_row(int n) {
    const bool roped = n < C_AV || (n >= C_RQ && n < C_RV);
    if (!roped) return n;
    const int d = n & 127, hb = d >> 6, nn = (d >> 5) & 1, w1 = (d >> 4) & 1, fq = (d >> 2) & 3, i = d & 3;
    return (n & ~127) + 32 * (2 * hb + w1) + 8 * fq + 4 * nn + i;
}
__device__ __forceinline__ void p0_transpose_item(const float* W, int K, int N, bf16* WT, int ldt, bool permrows, const float* rowscale, LAS float* scr, int item, int lane) {
    const int nblk = N / 32, kb = item / nblk, nb = item % nblk, k0 = 64 * kb, n0 = 32 * nb;
    if (rowscale) {
#pragma unroll 8
        for (int i = 0; i < 32; ++i) { const int kk = 2 * i + (lane >> 5); scr[kk * 33 + (lane & 31)] = W[(size_t)(k0 + kk) * N + n0 + (lane & 31)] * rowscale[k0 + kk]; }
    } else {
#pragma unroll 8
        for (int i = 0; i < 32; ++i) { const int kk = 2 * i + (lane >> 5); scr[kk * 33 + (lane & 31)] = W[(size_t)(k0 + kk) * N + n0 + (lane & 31)]; }
    }
    LDS_WAIT(); asm volatile("" ::: "memory");
    const int c = lane & 7;
#pragma unroll
    for (int j = 0; j < 4; ++j) { const int n = (lane >> 3) + 8 * j; const LAS float* s = scr + (8 * c) * 33 + n;
        v4u o; o.x = pk2(s[0 * 33], s[1 * 33]); o.y = pk2(s[2 * 33], s[3 * 33]); o.z = pk2(s[4 * 33], s[5 * 33]); o.w = pk2(s[6 * 33], s[7 * 33]);
        *(GAS v4u*)(WT + (size_t)(permrows ? rope_perm_row(n0 + n) : n0 + n) * ldt + k0 + 8 * c) = o; }
    LDS_WAIT(); asm volatile("" ::: "memory");
}
__device__ __forceinline__ void rms_row_to_bf16(const float* xrow, const float* g, bf16* orow, int lane) {
    const GAS f32x4* xr = (const GAS f32x4*)xrow + lane;
    f32x4 v[16]; float s = 0.f;
#pragma unroll
    for (int j = 0; j < 16; ++j) { v[j] = xr[64 * j]; s += (v[j].x * v[j].x + v[j].y * v[j].y) + (v[j].z * v[j].z + v[j].w * v[j].w); }
    const float rstd = 1.f / sqrtf(wave_sum(s) * (1.f / DM) + EPS);
    GAS unsigned long long* o8 = (GAS unsigned long long*)orow + lane;
    const GAS f32x4* gr = (const GAS f32x4*)g + lane;
#pragma unroll
    for (int j = 0; j < 16; ++j) { const f32x4 gg = gr[64 * j]; o8[64 * j] = (unsigned long long)cvtpk(v[j].x * rstd * gg.x, v[j].y * rstd * gg.y) | ((unsigned long long)cvtpk(v[j].z * rstd * gg.z, v[j].w * rstd * gg.w) << 32); }
}
__device__ __forceinline__ void row_f32_to_bf16_rstd(const float* xrow, bf16* brow, float* rstd_out, int lane) {
    const GAS f32x4* xr = (const GAS f32x4*)xrow + lane;
    f32x4 v[16]; float s = 0.f;
#pragma unroll
    for (int j = 0; j < 16; ++j) { v[j] = xr[64 * j]; s += (v[j].x * v[j].x + v[j].y * v[j].y) + (v[j].z * v[j].z + v[j].w * v[j].w); }
    GAS unsigned long long* b8 = (GAS unsigned long long*)brow + lane;
#pragma unroll
    for (int j = 0; j < 16; ++j) b8[64 * j] = (unsigned long long)cvtpk(v[j].x, v[j].y) | ((unsigned long long)cvtpk(v[j].z, v[j].w) << 32);
    const float rstd = 1.f / sqrtf(wave_sum(s) * (1.f / DM) + EPS);
    if (lane == 0) *rstd_out = rstd;
}
__device__ __forceinline__ void row_bf16_rstd(const bf16* xrow, float* rstd_out, int lane) {
    bf16x8 v[8]; float s = 0.f;
#pragma unroll
    for (int j = 0; j < 8; ++j) v[j] = ld8(xrow + (size_t)(64 * j + lane) * 8);
#pragma unroll
    for (int j = 0; j < 8; ++j) { float f[8]; unpack8(v[j], f);
#pragma unroll
        for (int i = 0; i < 8; ++i) s += f[i] * f[i]; }
    const float rstd = 1.f / sqrtf(wave_sum(s) * (1.f / DM) + EPS);
    if (lane == 0) *rstd_out = rstd;
}
__device__ __forceinline__ void rms_row_bf16_to_f32(const bf16* xrow, const float* g, float* orow, int lane, bool poison) {
    bf16x8 v[8]; float s = 0.f;
#pragma unroll
    for (int j = 0; j < 8; ++j) { v[j] = ld8(xrow + (size_t)(64 * j + lane) * 8); float f[8]; unpack8(v[j], f);
#pragma unroll
        for (int i = 0; i < 8; ++i) s += f[i] * f[i]; }
    float rstd = 1.f / sqrtf(wave_sum(s) * (1.f / DM) + EPS); if (poison) rstd = __builtin_nanf("");
#pragma unroll
    for (int j = 0; j < 8; ++j) { float f[8]; unpack8(v[j], f); const GAS f32x4* gr = (const GAS f32x4*)(g + (size_t)(64 * j + lane) * 8); const f32x4 g0 = gr[0], g1 = gr[1];
        GAS f32x4* o4 = (GAS f32x4*)(orow + (size_t)(64 * j + lane) * 8);
        o4[0] = (f32x4){f[0] * rstd * g0.x, f[1] * rstd * g0.y, f[2] * rstd * g0.z, f[3] * rstd * g0.w}; o4[1] = (f32x4){f[4] * rstd * g1.x, f[5] * rstd * g1.y, f[6] * rstd * g1.z, f[7] * rstd * g1.w}; }
}
__device__ __forceinline__ void rms_row_to_f32(const float* xrow, const float* g, float* orow, int lane, bool poison) {
    const GAS f32x4* xr = (const GAS f32x4*)xrow + lane;
    f32x4 v[16]; float s = 0.f;
#pragma unroll
    for (int j = 0; j < 16; ++j) { v[j] = xr[64 * j]; s += (v[j].x * v[j].x + v[j].y * v[j].y) + (v[j].z * v[j].z + v[j].w * v[j].w); }
    float rstd = 1.f / sqrtf(wave_sum(s) * (1.f / DM) + EPS);
    if (poison) rstd = __builtin_nanf("");
    GAS f32x4* o4 = (GAS f32x4*)orow + lane;
    const GAS f32x4* gr = (const GAS f32x4*)g + lane;
#pragma unroll
    for (int j = 0; j < 16; ++j) { const f32x4 gg = gr[64 * j]; o4[64 * j] = v[j] * rstd * gg; }
}

struct Args { const float* in[10]; float* out; unsigned char* ws; int ph_lo, ph_hi; };

__global__ void __launch_bounds__(NWAVES * 64, 2) hymba_fwd(Args args) {
    extern __shared__ __attribute__((aligned(16))) unsigned char lds[];
    Frame F;
    F.lds = (LAS unsigned char*)lds;
    F.MISC = (volatile LAS unsigned*)(F.lds + MISC_OFF);
    F.tid = threadIdx.x; F.lane = F.tid & 63; F.wave = __builtin_amdgcn_readfirstlane(F.tid >> 6);
    F.G = gridDim.x; { const int bx = blockIdx.x; F.vcu = (F.G % 8 == 0) ? (bx % 8) * (F.G / 8) + bx / 8 : bx; }
    unsigned char* ws = args.ws;
    F.ctl = (gu32*)(ws + WS_CTL);
    const float* x_in = args.in[0]; const float* norm_w = args.in[1]; const float* w_in = args.in[2]; const float* q_norm = args.in[3]; const float* k_norm = args.in[4];
    const float* dec_f = args.in[5]; const float* dec_b = args.in[6]; const float* ret_norm = args.in[7]; const float* w_out = args.in[8]; const float* final_norm = args.in[9];
    float* ROPE = (float*)(ws + WS_ROPE); float* LG2T = ROPE + 4096;
    bf16* WIN = (bf16*)(ws + WS_WIN); bf16* WOUT = (bf16*)(ws + WS_WOUT); bf16* XCUR = (bf16*)(ws + WS_XCUR); float* RSTD = (float*)(ws + WS_XN); float* SSX = (float*)(ws + WS_XN + MiB);
    bf16* GA = (bf16*)(ws + WS_GA); bf16* RV = (bf16*)(ws + WS_RV); bf16* GR = (bf16*)(ws + WS_GR); float* SSQ = (float*)(ws + WS_SSQ); float* SSK = (float*)(ws + WS_SSK);
    bf16* MIX = (bf16*)(ws + WS_MIX); bf16* FST = (bf16*)(ws + WS_FST);
    bf16* QC = (bf16*)(ws + WS_QC); bf16* KC = (bf16*)(ws + WS_KC); bf16* VC = (bf16*)(ws + WS_VC); bf16* RQC = (bf16*)(ws + WS_RQC); bf16* RKC = (bf16*)(ws + WS_RKC);
    for (int u = F.tid; u < (LDS_BYTES - LDSCTL_OFF) / 4; u += NWAVES * 64) ((LAS unsigned*)(F.lds + LDSCTL_OFF))[u] = 0u;
    __syncthreads();
    XcdBarrier bar; bar.bar = (unsigned*)(F.ctl + CW_BAR); bar.x = 0; bar.st = nullptr;
    if (!MK_PER_PHASE) bar = xcd_barrier_post((unsigned*)(F.ctl + CW_BAR), F.MISC + 8);
#define GRID_BAR() do { if (!MK_PER_PHASE) xcd_barrier(bar); } while (0)
    const int lo = args.ph_lo, hi = args.ph_hi;
#define IN(k) (lo <= (k) && (k) < hi)
#define BOTH(k) (IN(k) && IN((k) + 1))
    const int gw = F.vcu * NWAVES + F.wave, NGW = F.G * NWAVES;

    if (PH_EN(0) && IN(0)) {
        LAS float* scr = (LAS float*)(F.lds + F.wave * 16384);
        constexpr int I_IN = (DM / 64) * (NIN / 32), I_OUT = (DM / 64) * (DM / 32), I_L = I_IN + I_OUT;
        for (int rep = 0; rep < DUP(0); ++rep)
        for (int it = gw; it < DEPTH * I_L; it += NGW) {
            const int l = it / I_L, r = it % I_L;
            if (r < I_IN) p0_transpose_item(w_in + (size_t)l * DM * NIN, DM, NIN, WIN + (size_t)l * NIN * KP, KP, true, norm_w + (size_t)l * DM, scr, r, F.lane);
            else p0_transpose_item(w_out + (size_t)l * DM * DM, DM, DM, WOUT + (size_t)l * DM * KP, KP, false, nullptr, scr, r - I_IN, F.lane);
        }
        const int gt = blockIdx.x * (NWAVES * 64) + F.tid;
        if (gt < 2048) {
            const int pos = gt >> 5, jf = gt & 31;
            double inv = 1.0; for (int i = 0; i < jf; ++i) inv *= 0.74989420933245582730;
            const float angf = (float)pos * (float)inv;
            const double a = (double)angf, kq = __builtin_rint(a * 0.63661977236758134308), rr = (a - kq * 1.5707963267948966192) - kq * 6.123233995736766e-17, r2 = rr * rr;
            const double sn = rr * (1.0 + r2 * (-1.0 / 6 + r2 * (1.0 / 120 + r2 * (-1.0 / 5040 + r2 * (1.0 / 362880 + r2 * (-1.0 / 39916800 + r2 * (1.0 / 6227020800.0)))))));
            const double cs = 1.0 + r2 * (-0.5 + r2 * (1.0 / 24 + r2 * (-1.0 / 720 + r2 * (1.0 / 40320 + r2 * (-1.0 / 3628800 + r2 * (1.0 / 479001600.0 + r2 * (-1.0 / 87178291200.0)))))));
            const int qd = ((int)kq) & 3;
            const double c = qd == 0 ? cs : qd == 1 ? -sn : qd == 2 ? -cs : sn, s = qd == 0 ? sn : qd == 1 ? cs : qd == 2 ? -sn : -cs;
            ROPE[gt] = (float)c; ROPE[2048 + gt] = (float)s;
        }
        if (gt < 2 * DEPTH * RH) LG2T[gt] = log2_sigmoid((gt < DEPTH * RH ? dec_f : dec_b)[gt % (DEPTH * RH)]);
        if (BOTH(0)) GRID_BAR();
    }

    for (int l = 0; l < DEPTH; ++l) {
        const int pb = 1 + 5 * l;
        if (PH_EN(1) && IN(pb)) {
            int tn_ = threadIdx.x; asm volatile("" : "+v"(tn_)); const int ln = tn_ & 63;
            int gwn = gw; asm volatile("" : "+s"(gwn));
            if (l == 0) { for (int m = gwn; m < M; m += NGW) row_f32_to_bf16_rstd(x_in + (size_t)m * DM, XCUR + (size_t)m * DM, RSTD + m, ln); }
            else { for (int m8 = gwn * 8; m8 < M; m8 += NGW * 8) {
                    const GAS f32x4* sp = (const GAS f32x4*)(SSX + (size_t)(m8 + (ln >> 3)) * 64 + 8 * (ln & 7)); const f32x4 a = sp[0], b = sp[1];
                    float t = ((a.x + a.y) + (a.z + a.w)) + ((b.x + b.y) + (b.z + b.w)); t = xsum8(t);
                    if ((ln & 7) == 0) RSTD[m8 + (ln >> 3)] = 1.f / sqrtf(t * (1.f / DM) + EPS); } }
            if (BOTH(pb)) GRID_BAR();
        }
        if (PH_EN(2) && IN(pb + 1)) {
            pg8::Gemm g{XCUR, WIN + (size_t)l * NIN * KP, M, NIN, DM, DM}; pg8::StaticOrder S; S.init(M, NIN, F.G, (int)blockIdx.x);
            { int tc_ = threadIdx.x; asm volatile("" : "+v"(tc_));
              LAS f32x4* rl = (LAS f32x4*)(F.lds + ROPE_LDS); const GAS f32x4* rg = (const GAS f32x4*)ROPE; rl[tc_] = rg[tc_]; rl[tc_ + 512] = rg[tc_ + 512];
              if (tc_ < 64) { LAS f32x4* gl = (LAS f32x4*)(F.lds + GAIN_LDS); gl[tc_] = tc_ < 32 ? ((const GAS f32x4*)(q_norm + l * 128))[tc_] : ((const GAS f32x4*)(k_norm + l * 128))[tc_ - 32]; }
              { pg8::Unit u0; S.next(0, u0);
                ((LAS f32x4*)(F.lds + RSTD_LDS))[tc_] = ((const GAS f32x4*)(RSTD + (size_t)(u0.pm & ~7) * 256))[tc_]; }
              __syncthreads(); }
            pg8::EpiProj E{QC, KC, VC, RQC, RKC, GA, RV, GR, SSQ, SSK, (LAS const float*)(F.lds + ROPE_LDS), (LAS const float*)(F.lds + GAIN_LDS), (LAS const float*)(F.lds + GAIN_LDS + 512), (LAS const float*)(F.lds + RSTD_LDS)};
            pg8::gemm_phase<pg8::EpiProj, pg8::StaticOrder, false, true>(F.lds, g, S, E);
            if (DUP(2) == 2) { __syncthreads(); pg8::gemm_phase<pg8::EpiProj, pg8::StaticOrder, false, true>(F.lds, g, S, E); }
            if (BOTH(pb + 1)) GRID_BAR();
        }
        if (PH_EN(4) && IN(pb + 2)) {
            { int tk_ = threadIdx.x; asm volatile("" : "+v"(tk_)); const int lnk = tk_ & 63; int gwk = gw; asm volatile("" : "+s"(gwk));
              for (int r4 = gwk; r4 < M * NHKV / 4; r4 += NGW) { const int hr = r4 * 4 + (lnk >> 4);
                const int s = hr & (SEQ - 1), bk = hr >> 12, kvh = bk & 3, bb = bk >> 2; const f32x4 pk = *(const f32x4*)(SSK + (((size_t)bb * SEQ + s) * 4 + kvh) * 4);
                const float rk = 1.f / sqrtf(((pk.x + pk.y) + (pk.z + pk.w)) * (1.f / 128.f) + EPS); bf16* kp = KC + (size_t)hr * 128 + (lnk & 15) * 8; *(bf16x8*)kp = scale8(ld8(kp), rk); } }
            for (int rep = 0; rep < DUP(4); ++rep)
            for (int u = F.vcu; u < BATCH * RH * 2 * 4; u += F.G) {
                const int es = u & 3, dir = (u >> 2) & 1, h = (u >> 3) & 7, b = u >> 6;
                const float lg2 = LG2T[(dir * DEPTH + l) * RH + h];
                scan_unit(b, h, dir, es, RV, RKC, FST, lg2, (char*)lds);
            }
            if (BOTH(pb + 2)) GRID_BAR();
        }
        if (PH_EN(5) && IN(pb + 3)) {
            bool nomax;
            { int ta_ = threadIdx.x; asm volatile("" : "+v"(ta_)); const int la_ = ta_ & 63;
              float gq = fmaxf(fabsf(q_norm[l * 128 + la_]), fabsf(q_norm[l * 128 + 64 + la_])), gk = fmaxf(fabsf(k_norm[l * 128 + la_]), fabsf(k_norm[l * 128 + 64 + la_]));
              gq = wave_max(gq); gk = wave_max(gk);
              const float bound = 128.f * ATT_SCALE * 1.4426950408889634f * 1.05f * gq * gk;
              nomax = __builtin_amdgcn_readfirstlane((int)(bound <= 60.f)) != 0; }
            for (int rep = 0; rep < DUP(5); ++rep)
            if (PH_EN(8)) for (int u = F.vcu; u < BATCH * NHQ * (SEQ / 256); u += F.G) {
                const int qb = u & 15, g = (u >> 4) & 3, bk = u >> 6, kvh = bk & 3, b = bk >> 2, head = kvh * 4 + g;
                const size_t r0 = (size_t)b * SEQ + (size_t)qb * 256;
                const bf16* Qb_ = QC + ((size_t)(b * NHQ + head) * SEQ + (size_t)qb * 256) * 128; const bf16* Kh_ = KC + (size_t)(b * NHKV + kvh) * SEQ * 128; const bf16* Vh_ = VC + (size_t)(b * NHKV + kvh) * SEQ * 128;
                const bf16* Gb_ = GA + ((size_t)(b * NHQ + head) * SEQ + (size_t)qb * 256) * 128; const float* sq_ = SSQ + (r0 * 16 + head) * 4; bf16* Ob_ = MIX + r0 * KP + head * 128;
#if ATT_PROBE
                attn_unit_pp<ATT_PROBE, true>(Qb_, Kh_, Vh_, Gb_, sq_, Ob_, (char*)lds, F.lds);
#endif
#if PP16
                if (nomax) attn_unit_p16(Qb_, Kh_, Vh_, Gb_, sq_, Ob_, (char*)lds, F.lds);
#else
                if (nomax) attn_unit_pp<0, true>(Qb_, Kh_, Vh_, Gb_, sq_, Ob_, (char*)lds, F.lds);
#endif
                else attn_unit_pp<0, false>(Qb_, Kh_, Vh_, Gb_, sq_, Ob_, (char*)lds, F.lds);
            }
            if (PH_EN(9)) for (int it = 0;; ++it) {
                volatile LAS unsigned* slot = F.MISC + 16 + (it & 1);
                if (threadIdx.x == 0) *slot = __hip_atomic_fetch_add((unsigned*)(F.ctl + CW_QUEUE + 64 * l), 1u, __ATOMIC_RELAXED, __HIP_MEMORY_SCOPE_AGENT);
                __syncthreads();
                const int u = (int)*slot;
                if (u >= BATCH * RH * NCH) break;
                const int j = u & 31, h = (u >> 5) & 7, b = u >> 8;
                const float lgf2 = LG2T[l * RH + h], lgb2 = LG2T[(DEPTH + l) * RH + h];
                ret_out_unit(b, h, j, RV, GR, RQC, RKC, FST, MIX, ret_norm + ((size_t)l * RH + h) * 256, lgf2, lgb2, (char*)lds);
            }
            if (BOTH(pb + 3)) GRID_BAR();
        }
        if (PH_EN(6) && IN(pb + 4)) {
            pg8::Gemm g{MIX, WOUT + (size_t)l * DM * KP, M, DM, DM, KP}; pg8::StaticOrder S; S.init(M, DM, F.G, (int)blockIdx.x);
            pg8::EpiResBf16 E{XCUR, DM, SSX};
            pg8::gemm_phase<pg8::EpiResBf16, pg8::StaticOrder, false, true>(F.lds, g, S, E);
            if (DUP(7) == 2 && l == 0) { __syncthreads(); pg8::gemm_phase<pg8::EpiResBf16, pg8::StaticOrder, true, true>(F.lds, g, S, E); }
            if (BOTH(pb + 4)) GRID_BAR();
        }
    }
    if (PH_EN(7) && IN(NPH - 1)) {
        const bool poison = !MK_PER_PHASE && (xb_ld(&bar.bar[XB_TMO]) != 0u);
        int tf_ = threadIdx.x; asm volatile("" : "+v"(tf_)); const int lnf = tf_ & 63;
        int gwf = gw; asm volatile("" : "+s"(gwf));
        for (int m = gwf; m < M; m += NGW) rms_row_bf16_to_f32(XCUR + (size_t)m * DM, final_norm, args.out + (size_t)m * DM, lnf, poison);
    }
#undef IN
#undef BOTH
#undef GRID_BAR
}

extern "C" void kernel_launch(void* const* d_in, const int* in_sizes, int n_in, void* d_out, int out_size, void* d_ws, size_t ws_size, hipStream_t stream) {
    static int grid = 0;
    if (grid == 0) {
        if (n_in != 10 || in_sizes[0] != M * DM || out_size != M * DM || ws_size < WS_END) {
            fprintf(stderr, "kernel_launch: shape/workspace mismatch: n_in %d in0 %d out %d ws %zu (need %zu); nothing launched\n", n_in, n_in > 0 ? in_sizes[0] : -1, out_size, ws_size, (size_t)WS_END); grid = -1; return; }
        int dev = 0, cus = 0, per_cu = 0;
        if (hipGetDevice(&dev) != hipSuccess || hipDeviceGetAttribute(&cus, hipDeviceAttributeMultiprocessorCount, dev) != hipSuccess) { fprintf(stderr, "kernel_launch: device query failed\n"); grid = -1; return; }
        if (hipFuncSetAttribute((const void*)hymba_fwd, hipFuncAttributeMaxDynamicSharedMemorySize, LDS_BYTES) != hipSuccess) { fprintf(stderr, "kernel_launch: hipFuncSetAttribute failed\n"); grid = -1; return; }
        if (hipOccupancyMaxActiveBlocksPerMultiprocessor(&per_cu, (const void*)hymba_fwd, NWAVES * 64, LDS_BYTES) != hipSuccess || per_cu < 1)
            fprintf(stderr, "kernel_launch: note: occupancy query reports %d workgroups per CU\n", per_cu);
        (void)hipGetLastError();
        grid = cus >= 8 ? (cus & ~7) : cus;
        if (grid % 8 != 0) { fprintf(stderr, "kernel_launch: needs at least 8 CUs\n"); grid = -1; return; }
    }
    if (grid < 0) return;
    if (hipMemsetAsync((char*)d_ws + WS_CTL, 0, CTL_ZERO_BYTES, stream) != hipSuccess) { fprintf(stderr, "kernel_launch: memset failed\n"); return; }
    Args a{};
    for (int i = 0; i < 10; ++i) a.in[i] = (const float*)d_in[i];
    a.out = (float*)d_out; a.ws = (unsigned char*)d_ws;
#if MK_PER_PHASE
    for (int p = 0; p < NPH; ++p) { a.ph_lo = p; a.ph_hi = p + 1; hipLaunchKernelGGL(hymba_fwd, dim3(grid), dim3(NWAVES * 64), LDS_BYTES, stream, a); }
#else
    a.ph_lo = 0; a.ph_hi = NPH; hipLaunchKernelGGL(hymba_fwd, dim3(grid), dim3(NWAVES * 64), LDS_BYTES, stream, a);
#endif
    const hipError_t le = hipPeekAtLastError();
    if (le != hipSuccess) fprintf(stderr, "kernel_launch: launch failed: %s\n", hipGetErrorName(le));
}
```

```cpp
#include <hip/hip_runtime.h>
#include <cstdio>
#include <cstdint>
namespace pg8 {
#define PG8_LAS __attribute__((address_space(3)))
typedef unsigned short bf16_t;
typedef short bf16x8 __attribute__((ext_vector_type(8)));
typedef float f32x4 __attribute__((ext_vector_type(4)));
typedef unsigned u32x4 __attribute__((ext_vector_type(4)));
constexpr int BM = 256, BK = 64, HALF = 128, HTB = HALF * BK * 2  , STAGE_BYTES = 8 * HTB, NXCD = 8, WGM = 8;

__host__ __device__ __forceinline__ int lds_byte(int r, int c) { const int st = (r >> 4) * 2 + (c >> 5), rr = r & 15, cc = c & 31, ob = rr * 64 + cc * 2; return st * 1024 + (ob ^ (((ob >> 9) & 1) << 5)); }
__host__ __device__ __forceinline__ void stage_rc(int b, int& R, int& C) { const int st = b / 1024, sb = b % 1024, swz = sb ^ (((sb >> 9) & 1) << 5); R = (st >> 1) * 16 + swz / 64; C = (st & 1) * 32 + (swz % 64) / 2; }
__host__ __device__ __forceinline__ int perm32(int rho) { const int n = rho >> 4, i = rho & 15; return 8 * (i >> 2) + 4 * n + (i & 3); }

struct Unit { int pm, pn; };
struct Gemm { const bf16_t* A; const bf16_t* Bt; int M, N, K, ld; };

struct StaticOrder {
    int nM, nN, nwg, G, c, i0, i1;
    __host__ __device__ void init(int M, int N, int G_, int c_) { nM = M / BM; nN = N / BM; nwg = nM * nN; G = G_; c = c_; i0 = 0; i1 = 1 << 30; }
    __host__ __device__ bool next(int i, Unit& u) const {
        const int ii = i + i0; if (ii >= i1) return false;
        const long L = (long)ii * G + c; if (L >= nwg) return false;
        int wgid = (int)L; { const int q = nwg / NXCD, r = nwg % NXCD, xcd = wgid % NXCD, off = wgid / NXCD; wgid = (xcd < r ? xcd * (q + 1) : r * (q + 1) + (xcd - r) * q) + off; }
        const int nig = WGM * nN, gid = wgid / nig, fm = gid * WGM, gsz = (nM - fm) < WGM ? (nM - fm) : WGM;
        u.pm = fm + ((wgid % nig) % gsz); u.pn = (wgid % nig) / gsz; return true;
    }
    __device__ __forceinline__ void a_ready(const Unit&) const {}
    __device__ __forceinline__ void done(const Unit&) const {}
};

typedef float cvt_f32x2 __attribute__((ext_vector_type(2))); typedef __bf16 cvt_bf16x2 __attribute__((ext_vector_type(2)));
__device__ __forceinline__ unsigned cvt_pk_bf16(float lo, float hi) { cvt_f32x2 v = {lo, hi}; cvt_bf16x2 r = __builtin_convertvector(v, cvt_bf16x2); return __builtin_bit_cast(unsigned, r); }
typedef float f32x2 __attribute__((ext_vector_type(2)));
__device__ __forceinline__ f32x2 gelu_pk(f32x2 v) {
    const f32x2 av = __builtin_elementwise_abs(v), d = av * 0.2316418882f + 1.0f;
    f32x2 t; t.x = __builtin_amdgcn_rcpf(d.x); t.y = __builtin_amdgcn_rcpf(d.y);
    f32x2 q = t * 0.5307027145f + (-0.7265760135f); q = q * t + 0.7107068705f; q = q * t + (-0.142248368f); q = q * t + 0.127414796f; q = q * t;
    const f32x2 s = (v * v) * (-0.72134752044f);
    f32x2 e; e.x = __builtin_amdgcn_exp2f(s.x); e.y = __builtin_amdgcn_exp2f(s.y);
    const f32x2 m = v * (q * e), r = v - m;
    f32x2 o; o.x = v.x < 0.f ? m.x : r.x; o.y = v.y < 0.f ? m.y : r.y; return o;
}

template <int ACT  > struct EpiBf16 {
    static constexpr bool PERM = true, AFTER_DRAIN = false; static_assert(ACT == 0 || ACT == 1, "EpiBf16: ACT is 0 (none) or 1 (gelu_pk)");
    bf16_t* O; int ldc; const float* bias; int split_cols; size_t split_stride; float scale0;
    __device__ __forceinline__ void operator()(const f32x4 (&acc)[2][2][4][2], const Unit& u, int wr, int wc, int fr, int fq) const {
        const int row0 = u.pm * BM + wr * 64 + fr; int colt = u.pn * BM; bf16_t* base = O;
        float sc = 1.f; if (split_cols) { const int t = colt / split_cols; base += (size_t)t * split_stride; colt -= t * split_cols; if (t == 0) sc = scale0; }
        const int col0 = colt + wc * 32 + 8 * fq, bcol0 = u.pn * BM + wc * 32 + 8 * fq;
        f32x4 bv[2][2];
#pragma unroll
        for (int bj = 0; bj < 2; ++bj)
#pragma unroll
            for (int n = 0; n < 2; ++n) bv[bj][n] = bias ? *(const f32x4*)(bias + bcol0 + bj * HALF + 4 * n) : (f32x4){0.f, 0.f, 0.f, 0.f};
#pragma unroll
        for (int ai = 0; ai < 2; ++ai)
#pragma unroll
            for (int m = 0; m < 4; ++m) { bf16_t* rowp = base + (size_t)(row0 + ai * HALF + m * 16) * ldc + col0;
#pragma unroll
                for (int bj = 0; bj < 2; ++bj) { f32x4 v0 = acc[ai][bj][m][0] + bv[bj][0], v1 = acc[ai][bj][m][1] + bv[bj][1];
                    if (ACT == 1) { f32x2 a = gelu_pk((f32x2){v0[0], v0[1]}), b = gelu_pk((f32x2){v0[2], v0[3]}), c = gelu_pk((f32x2){v1[0], v1[1]}), d = gelu_pk((f32x2){v1[2], v1[3]});
                        v0 = (f32x4){a.x, a.y, b.x, b.y}; v1 = (f32x4){c.x, c.y, d.x, d.y}; }
                    v0 = v0 * sc; v1 = v1 * sc; u32x4 w; w.x = cvt_pk_bf16(v0[0], v0[1]); w.y = cvt_pk_bf16(v0[2], v0[3]); w.z = cvt_pk_bf16(v1[0], v1[1]); w.w = cvt_pk_bf16(v1[2], v1[3]);
                    *(u32x4*)(rowp + bj * HALF) = w; } }
    }
};
template <class Epi, class Sched, bool ALIGN_EPI = false, bool SP2 = false>
__device__ __forceinline__ void gemm_phase(PG8_LAS unsigned char* lds, const Gemm g, const Sched& S, const Epi& E) {
    int tid_ = threadIdx.x; asm volatile("" : "+v"(tid_));
    const int tid = tid_, wid = __builtin_amdgcn_readfirstlane(tid >> 6), lane = tid & 63, wr = wid >> 2, wc = wid & 3, fr = lane & 15, fq = lane >> 4;
    const int K = g.K, nt = K / BK, LD = g.ld;
    unsigned voffA[2], voffB[2];
#pragma unroll
    for (int i = 0; i < 2; ++i) { int R, C; stage_rc(tid * 16 + i * 8192, R, C); const int Rb = Epi::PERM ? ((R & ~31) + perm32(R & 31)) : R;
        voffA[i] = (unsigned)(R * LD + C) * 2u; voffB[i] = (unsigned)(Rb * LD + C) * 2u; }
    const size_t kstep = (size_t)(BK * 2);
    const size_t hstep = (size_t)HALF * LD * 2;
    const size_t tstep = 2 * hstep;
    const unsigned ldsw = (unsigned)wid * 1024u;
    const int aoff = lds_byte(wr * 64 + fr, fq * 8), boff = lds_byte(wc * 32 + fr, fq * 8);
#define PG8_SA(b, h) (((b) * 2 + (h)) * HTB)
#define PG8_SB(b, h) ((4 + (b) * 2 + (h)) * HTB)
#define PG8_STAGE(bufoff, gbase, voff) do { _Pragma("unroll") for (int _i = 0; _i < 2; ++_i) \
        __builtin_amdgcn_global_load_lds((const unsigned*)((const char*)(gbase) + (voff)[_i]), (PG8_LAS unsigned*)(lds + (bufoff) + ldsw + _i * 8192), 16, 0, 0); } while (0)
#define PG8_STAGE_K(bufoff, gbase, voff, keep) do { _Pragma("unroll") for (int _i = 0; _i < 2; ++_i) { keep[_i] = (const char*)(gbase) + (voff)[_i]; \
        __builtin_amdgcn_global_load_lds((const unsigned*)keep[_i], (PG8_LAS unsigned*)(lds + (bufoff) + ldsw + _i * 8192), 16, 0, 0); } } while (0)
#define PG8_STAGE_R(bufoff, keep) do { _Pragma("unroll") for (int _i = 0; _i < 2; ++_i) \
        __builtin_amdgcn_global_load_lds((const unsigned*)keep[_i], (PG8_LAS unsigned*)(lds + (bufoff) + ldsw + _i * 8192 - BK * 2), 16, BK * 2, 0); } while (0)
#define PG8_LDA(dst, b, h) do { _Pragma("unroll") for (int m = 0; m < 4; ++m) _Pragma("unroll") for (int k = 0; k < 2; ++k) dst[m][k] = *(const PG8_LAS bf16x8*)(lds + PG8_SA(b, h) + aoff + m * 2048 + k * 1024); } while (0)
#define PG8_LDB(dst, b, h) do { _Pragma("unroll") for (int n = 0; n < 2; ++n) _Pragma("unroll") for (int k = 0; k < 2; ++k) dst[n][k] = *(const PG8_LAS bf16x8*)(lds + PG8_SB(b, h) + boff + n * 2048 + k * 1024); } while (0)
#define PG8_MMA(ai, bj, At, Bt) do { __builtin_amdgcn_s_setprio(1); _Pragma("unroll") for (int m = 0; m < 4; ++m) _Pragma("unroll") for (int n = 0; n < 2; ++n) _Pragma("unroll") for (int k = 0; k < 2; ++k) \
        acc[ai][bj][m][n] = __builtin_amdgcn_mfma_f32_16x16x32_bf16(Bt[n][k], At[m][k], acc[ai][bj][m][n], 0, 0, 0); __builtin_amdgcn_s_setprio(0); } while (0)
#define PG8_WAIT_V(n) asm volatile("s_waitcnt vmcnt(" #n ")" ::: "memory")
#define PG8_WAIT_L(n) asm volatile("s_waitcnt lgkmcnt(" #n ")" ::: "memory")
#define PG8_BAR __builtin_amdgcn_s_barrier()
#define PG8_SCHED __builtin_amdgcn_sched_barrier(0)
    Unit cur, nxt; int ui = 0;
    if (!S.next(0, cur)) return;
    f32x4 acc[2][2][4][2];
#pragma unroll
    for (int a = 0; a < 2; ++a)
#pragma unroll
        for (int b = 0; b < 2; ++b)
#pragma unroll
            for (int m = 0; m < 4; ++m)
#pragma unroll
                for (int n = 0; n < 2; ++n) acc[a][b][m][n] = (f32x4){0.f, 0.f, 0.f, 0.f};
    bf16x8 At[4][2], B0[2][2], B1[2][2];
    const char* cA = (const char*)g.A + (size_t)cur.pm * tstep; const char* cB = (const char*)g.Bt + (size_t)cur.pn * tstep;
    S.a_ready(cur);
    if constexpr (SP2) {
        PG8_STAGE(PG8_SB(0, 0), cB, voffB); PG8_STAGE(PG8_SB(0, 1), cB + hstep, voffB); PG8_STAGE(PG8_SA(0, 0), cA, voffA); PG8_STAGE(PG8_SA(0, 1), cA + hstep, voffA);
        if (wr == 1) PG8_BAR;
        PG8_WAIT_V(2); PG8_BAR;
        PG8_STAGE(PG8_SB(1, 0), cB + kstep, voffB); PG8_STAGE(PG8_SA(1, 0), cA + kstep, voffA); PG8_STAGE(PG8_SB(1, 1), cB + hstep + kstep, voffB);
        PG8_WAIT_V(6); PG8_BAR;
    } else {
        PG8_STAGE(PG8_SB(0, 0), cB, voffB); PG8_STAGE(PG8_SA(0, 0), cA, voffA); PG8_STAGE(PG8_SB(0, 1), cB + hstep, voffB); PG8_STAGE(PG8_SA(0, 1), cA + hstep, voffA);
        if (wr == 1) PG8_BAR;
        PG8_WAIT_V(4); PG8_BAR;
        PG8_STAGE(PG8_SB(1, 0), cB + kstep, voffB); PG8_STAGE(PG8_SA(1, 0), cA + kstep, voffA); PG8_STAGE(PG8_SB(1, 1), cB + hstep + kstep, voffB);
        PG8_WAIT_V(6); PG8_BAR;
    }
    const char* kA0[2]; const char* kA1[2]; const char* kB0[2]; const char* kB1[2];
    if constexpr (SP2) { kA1[0] = cA + hstep + voffA[0]; kA1[1] = cA + hstep + voffA[1]; }
    for (;;) {
        const bool has_next = S.next(ui + 1, nxt);
        const char* nA = has_next ? (const char*)g.A + (size_t)nxt.pm * tstep : cA; const char* nB = has_next ? (const char*)g.Bt + (size_t)nxt.pn * tstep : cB;
        for (int t = 0; t < nt; t += 2) {
            const bool last = (t == nt - 2);
            const char* a1 = cA + (size_t)(t + 1) * kstep;
            const char* a2 = last ? nA : cA + (size_t)(t + 2) * kstep; const char* b2 = last ? nB : cB + (size_t)(t + 2) * kstep;
            const char* a3 = a2 + kstep; const char* b3 = b2 + kstep;
            if (last && has_next) S.a_ready(nxt);
            if constexpr (SP2) {
            PG8_LDB(B0, 0, 0); PG8_LDB(B1, 0, 1); PG8_SCHED; PG8_LDA(At, 0, 0); PG8_STAGE_R(PG8_SA(1, 1), kA1);
            PG8_WAIT_V(8); PG8_WAIT_L(0); PG8_BAR; PG8_MMA(0, 0, At, B0); PG8_MMA(0, 1, At, B1); PG8_BAR; PG8_SCHED;
            PG8_LDA(At, 0, 1); PG8_STAGE_K(PG8_SB(0, 0), b2, voffB, kB0); PG8_STAGE_K(PG8_SB(0, 1), b2 + hstep, voffB, kB1); PG8_STAGE_K(PG8_SA(0, 0), a2, voffA, kA0);
            PG8_WAIT_V(8); PG8_WAIT_L(0); PG8_BAR; PG8_MMA(1, 0, At, B0); PG8_MMA(1, 1, At, B1); PG8_BAR; PG8_SCHED;
            PG8_LDB(B0, 1, 0); PG8_LDB(B1, 1, 1); PG8_SCHED; PG8_LDA(At, 1, 0); PG8_STAGE_K(PG8_SA(0, 1), a2 + hstep, voffA, kA1);
            PG8_WAIT_V(8); PG8_WAIT_L(0); PG8_BAR; PG8_MMA(0, 0, At, B0); PG8_MMA(0, 1, At, B1); PG8_BAR; PG8_SCHED;
            PG8_LDA(At, 1, 1); PG8_STAGE_R(PG8_SB(1, 0), kB0); PG8_STAGE_R(PG8_SB(1, 1), kB1); PG8_STAGE_R(PG8_SA(1, 0), kA0);
            PG8_WAIT_V(8); PG8_WAIT_L(0); PG8_BAR; PG8_MMA(1, 0, At, B0); PG8_MMA(1, 1, At, B1); PG8_BAR; PG8_SCHED;
            } else {
            PG8_LDB(B0, 0, 0); PG8_SCHED; PG8_LDA(At, 0, 0); PG8_STAGE(PG8_SA(1, 1), a1 + hstep, voffA);
            PG8_WAIT_L(8); PG8_BAR; PG8_WAIT_L(0); PG8_MMA(0, 0, At, B0); PG8_BAR; PG8_SCHED;
            PG8_LDB(B1, 0, 1); PG8_STAGE(PG8_SB(0, 0), b2, voffB);
            PG8_BAR; PG8_WAIT_L(0); PG8_MMA(0, 1, At, B1); PG8_BAR;
            PG8_LDA(At, 0, 1); PG8_STAGE(PG8_SA(0, 0), a2, voffA);
            PG8_BAR; PG8_WAIT_L(0); PG8_MMA(1, 0, At, B0); PG8_BAR; PG8_SCHED;
            PG8_STAGE(PG8_SB(0, 1), b2 + hstep, voffB);
            PG8_WAIT_V(6); PG8_BAR; PG8_MMA(1, 1, At, B1); PG8_BAR;
            PG8_LDB(B0, 1, 0); PG8_SCHED; PG8_LDA(At, 1, 0); PG8_STAGE(PG8_SA(0, 1), a2 + hstep, voffA);
            PG8_WAIT_L(8); PG8_BAR; PG8_WAIT_L(0); PG8_MMA(0, 0, At, B0); PG8_BAR; PG8_SCHED;
            PG8_LDB(B1, 1, 1); PG8_STAGE(PG8_SB(1, 0), b3, voffB);
            PG8_BAR; PG8_WAIT_L(0); PG8_MMA(0, 1, At, B1); PG8_BAR;
            PG8_LDA(At, 1, 1); PG8_STAGE(PG8_SA(1, 0), a3, voffA);
            PG8_BAR; PG8_WAIT_L(0); PG8_MMA(1, 0, At, B0); PG8_BAR; PG8_SCHED;
            PG8_STAGE(PG8_SB(1, 1), b3 + hstep, voffB);
            PG8_WAIT_V(6); PG8_BAR; PG8_MMA(1, 1, At, B1); PG8_BAR;
            }
        }
        if constexpr (ALIGN_EPI) { if (wr == 0) PG8_BAR; }
        if constexpr (!Epi::AFTER_DRAIN) { E(acc, cur, wr, wc, fr, fq); S.done(cur); }
        if (!has_next) break;
#pragma unroll
        for (int a = 0; a < 2; ++a)
#pragma unroll
            for (int b = 0; b < 2; ++b)
#pragma unroll
                for (int m = 0; m < 4; ++m)
#pragma unroll
                    for (int n = 0; n < 2; ++n) acc[a][b][m][n] = (f32x4){0.f, 0.f, 0.f, 0.f};
        cur = nxt; cA = nA; cB = nB; ++ui;
        if constexpr (ALIGN_EPI) { if (wr == 1) PG8_BAR; }
    }
    PG8_WAIT_V(0);
    if constexpr (!ALIGN_EPI) { if (wr == 0) PG8_BAR; }
    PG8_BAR;
    if constexpr (Epi::AFTER_DRAIN) { E.fused(acc, cur, wr, wc, fr, fq, lds, wid, lane); S.done(cur); }
#undef PG8_SA
#undef PG8_SB
#undef PG8_STAGE
#undef PG8_STAGE_K
#undef PG8_STAGE_R
#undef PG8_LDA
#undef PG8_LDB
#undef PG8_MMA
#undef PG8_WAIT_V
#undef PG8_WAIT_L
#undef PG8_BAR
#undef PG8_SCHED
}
}
namespace pg8 {
__device__ __forceinline__ float opq(float x) { asm("" : "+v"(x)); return x; }
__device__ __forceinline__ float row4_sum(float v) {
    { auto r = __builtin_amdgcn_permlane16_swap(__float_as_uint(v), __float_as_uint(v), false, false); v = __uint_as_float(r[0]) + __uint_as_float(r[1]); }
    { auto r = __builtin_amdgcn_permlane32_swap(__float_as_uint(v), __float_as_uint(v), false, false); v = __uint_as_float(r[0]) + __uint_as_float(r[1]); }
    return v;
}
struct EpiResF32 {
    static constexpr bool PERM = false, AFTER_DRAIN = false;
    const float* base; float* out; int ldc;
    __device__ __forceinline__ void operator()(const f32x4 (&acc)[2][2][4][2], const Unit& u, int wr, int wc, int fr, int fq) const {
        const int row0 = u.pm * BM + wr * 64 + fr, col0 = u.pn * BM + wc * 32 + 4 * fq;
#pragma unroll
        for (int ai = 0; ai < 2; ++ai)
#pragma unroll
            for (int m = 0; m < 4; ++m) { const size_t off = (size_t)(row0 + ai * HALF + m * 16) * ldc + col0;
#pragma unroll
                for (int bj = 0; bj < 2; ++bj)
#pragma unroll
                    for (int n = 0; n < 2; ++n) { const f32x4 bs = *(const f32x4*)(base + off + bj * HALF + n * 16); *(f32x4*)(out + off + bj * HALF + n * 16) = bs + acc[ai][bj][m][n]; }
                asm volatile("" ::: "memory"); }
    }
};
struct EpiResBf16 {
    static constexpr bool PERM = true, AFTER_DRAIN = false;
    bf16_t* xb; int ld; float* ssx;
    __device__ __forceinline__ void operator()(const f32x4 (&acc)[2][2][4][2], const Unit& u, int wr, int wc, int fr, int fq) const {
        const int row0 = u.pm * BM + wr * 64 + fr, col0 = u.pn * BM + wc * 32 + 8 * fq;
        u32x4 bs[2][4][2];
#pragma unroll
        for (int ai = 0; ai < 2; ++ai)
#pragma unroll
            for (int m = 0; m < 4; ++m)
#pragma unroll
                for (int bj = 0; bj < 2; ++bj) bs[ai][m][bj] = *(const u32x4*)(xb + (size_t)(row0 + ai * HALF + m * 16) * ld + col0 + bj * HALF);
        asm volatile("" ::: "memory");
#pragma unroll
        for (int ai = 0; ai < 2; ++ai)
#pragma unroll
            for (int m = 0; m < 4; ++m) { const int row = row0 + ai * HALF + m * 16; bf16_t* rowp = xb + (size_t)row * ld + col0; float ss = 0.f;
#pragma unroll
                for (int bj = 0; bj < 2; ++bj) { const u32x4 b = bs[ai][m][bj]; const f32x4 a0 = acc[ai][bj][m][0], a1 = acc[ai][bj][m][1];
                    const f32x4 t0 = {opq(__uint_as_float(b.x << 16) + a0[0]), opq(__uint_as_float(b.x & 0xffff0000u) + a0[1]), opq(__uint_as_float(b.y << 16) + a0[2]), opq(__uint_as_float(b.y & 0xffff0000u) + a0[3])};
                    const f32x4 t1 = {opq(__uint_as_float(b.z << 16) + a1[0]), opq(__uint_as_float(b.z & 0xffff0000u) + a1[1]), opq(__uint_as_float(b.w << 16) + a1[2]), opq(__uint_as_float(b.w & 0xffff0000u) + a1[3])};
                    u32x4 w; w.x = cvt_pk_bf16(t0[0], t0[1]); w.y = cvt_pk_bf16(t0[2], t0[3]); w.z = cvt_pk_bf16(t1[0], t1[1]); w.w = cvt_pk_bf16(t1[2], t1[3]);
                    *(u32x4*)(rowp + bj * HALF) = w;
                    ss = fmaf(t0[0], t0[0], ss); ss = fmaf(t0[1], t0[1], ss); ss = fmaf(t0[2], t0[2], ss); ss = fmaf(t0[3], t0[3], ss); ss = fmaf(t1[0], t1[0], ss); ss = fmaf(t1[1], t1[1], ss); ss = fmaf(t1[2], t1[2], ss); ss = fmaf(t1[3], t1[3], ss); }
                ss = row4_sum(ss);
                if (fq == 0) ssx[(size_t)row * 64 + u.pn * 4 + wc] = ss; }
    }
};
struct EpiProj {
    static constexpr bool PERM = true, AFTER_DRAIN = false;
    bf16_t *QC, *KC, *VC, *RQC, *RKC, *GA, *RV, *GR; float *ssq, *ssk; PG8_LAS const float* rope; PG8_LAS const float* qn; PG8_LAS const float* kn; PG8_LAS const float* rs;
    __device__ __forceinline__ void operator()(const f32x4 (&acc)[2][2][4][2], const Unit& u, int wr, int wc, int fr, int fq) const {
        constexpr int SEQ_ = 4096; constexpr float RSC = 0.088388347648318440f;
        const int pn = u.pn, bb = (u.pm * BM) >> 12, srow0 = ((u.pm * BM) & (SEQ_ - 1)) + wr * 64 + fr;
        int mode, nh = 0, hd = 0; bf16_t* base; size_t rowpitch, bjstride; float* ssp = nullptr; PG8_LAS const float* gsrc = nullptr; float rsc = 1.f;
        if (pn < 8)       { mode = 2; nh = 16; hd = 2 * pn;        base = QC + (size_t)(bb * 16 + hd) * SEQ_ * 128; rowpitch = 128; bjstride = (size_t)SEQ_ * 128; ssp = ssq; gsrc = qn; }
        else if (pn < 10) { mode = 2; nh = 4;  hd = 2 * (pn - 8);  base = KC + (size_t)(bb * 4 + hd) * SEQ_ * 128;  rowpitch = 128; bjstride = (size_t)SEQ_ * 128; ssp = ssk; gsrc = kn; }
        else if (pn < 12) { mode = 0;          hd = 2 * (pn - 10); base = VC + (size_t)(bb * 4 + hd) * SEQ_ * 128;  rowpitch = 128; bjstride = (size_t)SEQ_ * 128; }
        else if (pn < 20) { mode = 0;          hd = 2 * (pn - 12); base = GA + (size_t)(bb * 16 + hd) * SEQ_ * 128; rowpitch = 128; bjstride = (size_t)SEQ_ * 128; }
        else if (pn < 24) { mode = 1;          hd = 2 * (pn - 20); base = RQC + (size_t)(bb * 8 + hd) * SEQ_ * 128; rowpitch = 128; bjstride = (size_t)SEQ_ * 128; }
        else if (pn < 28) { mode = 1;          hd = 2 * (pn - 24); base = RKC + (size_t)(bb * 8 + hd) * SEQ_ * 128; rowpitch = 128; bjstride = (size_t)SEQ_ * 128; rsc = RSC; }
        else if (pn < 36) { mode = 0; base = RV + (size_t)(bb * 8 + (pn - 28)) * SEQ_ * 256; rowpitch = 256; bjstride = 128; }
        else              { mode = 0; base = GR + (size_t)(bb * 8 + (pn - 36)) * SEQ_ * 256; rowpitch = 256; bjstride = 128; }
        bf16_t* const dst0 = base + wc * 32 + 8 * fq;
        PG8_LAS const float* const rsp = rs + (u.pm & 7) * BM + wr * 64 + fr;
        if (mode == 0) {
#pragma unroll
            for (int ai = 0; ai < 2; ++ai)
#pragma unroll
                for (int m = 0; m < 4; ++m) { bf16_t* rowp = dst0 + (size_t)(srow0 + ai * HALF + m * 16) * rowpitch; const float rr = rsp[ai * HALF + m * 16];
#pragma unroll
                    for (int bj = 0; bj < 2; ++bj) { const f32x4 a0 = acc[ai][bj][m][0], a1 = acc[ai][bj][m][1];
                        u32x4 w; w.x = cvt_pk_bf16(opq(a0[0] * rr), opq(a0[1] * rr)); w.y = cvt_pk_bf16(opq(a0[2] * rr), opq(a0[3] * rr)); w.z = cvt_pk_bf16(opq(a1[0] * rr), opq(a1[1] * rr)); w.w = cvt_pk_bf16(opq(a1[2] * rr), opq(a1[3] * rr));
                        *(u32x4*)(rowp + bj * bjstride) = w; } }
            return;
        }
        const int hb = wc >> 1, j0 = 16 * (wc & 1) + 4 * fq;
        f32x4 g1 = {1.f, 1.f, 1.f, 1.f}, g2 = g1;
        if (mode == 2) { g1 = *(PG8_LAS const f32x4*)(gsrc + 64 * hb + j0); g2 = *(PG8_LAS const f32x4*)(gsrc + 64 * hb + 32 + j0); }
#pragma unroll
        for (int ai = 0; ai < 2; ++ai) {
            f32x4 cs[4], sn[4]; float rr[4];
#pragma unroll
            for (int m = 0; m < 4; ++m) { const int s = srow0 + ai * HALF + m * 16, pos = hb ? (s & 63) : (s >> 6); cs[m] = *(PG8_LAS const f32x4*)(rope + pos * 32 + j0); sn[m] = *(PG8_LAS const f32x4*)(rope + 2048 + pos * 32 + j0); rr[m] = rsp[ai * HALF + m * 16]; }
#pragma unroll
            for (int m = 0; m < 4; ++m) { const int s = srow0 + ai * HALF + m * 16; bf16_t* rowp = dst0 + (size_t)s * rowpitch; const float rq = rr[m] * rsc; f32x4 h1, h2;
#pragma unroll
                for (int i = 0; i < 4; ++i) { h1[i] = opq(g1[i] * rq); h2[i] = opq(g2[i] * rq); }
#pragma unroll
                for (int bj = 0; bj < 2; ++bj) { const f32x4 x1 = acc[ai][bj][m][0], x2 = acc[ai][bj][m][1];
                    f32x4 o1, o2;
#pragma unroll
                    for (int i = 0; i < 4; ++i) { const float y1 = opq(x1[i] * h1[i]), y2 = opq(x2[i] * h2[i]), c = cs[m][i], sv = sn[m][i]; o1[i] = opq(fmaf(y1, c, -opq(y2 * sv))); o2[i] = opq(fmaf(y1, sv, opq(y2 * c))); }
                    u32x4 w; w.x = cvt_pk_bf16(o1[0], o1[1]); w.y = cvt_pk_bf16(o1[2], o1[3]); w.z = cvt_pk_bf16(o2[0], o2[1]); w.w = cvt_pk_bf16(o2[2], o2[3]);
                    *(u32x4*)(rowp + bj * bjstride) = w;
                    if (mode == 2) { float ss = x1[0] * x1[0];
                        ss = fmaf(x1[1], x1[1], ss); ss = fmaf(x1[2], x1[2], ss); ss = fmaf(x1[3], x1[3], ss); ss = fmaf(x2[0], x2[0], ss); ss = fmaf(x2[1], x2[1], ss); ss = fmaf(x2[2], x2[2], ss); ss = fmaf(x2[3], x2[3], ss);
                        ss = row4_sum(ss);
                        if (fq == 0) ssp[(((size_t)bb * SEQ_ + s) * nh + hd + bj) * 4 + wc] = ss * (rr[m] * rr[m]); } } }
        }
    }
};
}
#define GAS __attribute__((address_space(1)))
#define LAS __attribute__((address_space(3)))
typedef unsigned short bf16;
typedef unsigned v4u __attribute__((ext_vector_type(4)));
typedef float f32x4 __attribute__((ext_vector_type(4)));
typedef short bf16x8 __attribute__((ext_vector_type(8)));
typedef GAS unsigned gu32;
typedef GAS unsigned long long gu64;
#define RLX_AGENT __ATOMIC_RELAXED, __HIP_MEMORY_SCOPE_AGENT
#define LDS_WAIT() asm volatile("s_waitcnt lgkmcnt(0)" ::: "memory")
#define VM_WAIT() asm volatile("s_waitcnt vmcnt(0)" ::: "memory")
__device__ __forceinline__ unsigned long long rt() { return __builtin_amdgcn_s_memrealtime(); }
__device__ __forceinline__ unsigned f2bf(float f) { unsigned u = __builtin_bit_cast(unsigned, f); return (u + 0x7fffu + ((u >> 16) & 1u)) >> 16; }
__device__ __forceinline__ unsigned pk2(float lo, float hi) { return f2bf(lo) | (f2bf(hi) << 16); }

#define XB_TMO      128
#define XB_XCNT(j)  (256  + 64 * (j))
#define XB_XSUB(j)  (1280 + 64 * (j))
#define XB_XGEN(j)  (2304 + 64 * (j))
#define XB_TOP      3328
#define XB_TOPGEN   3392
#define XCD_BAR_WORDS 3456
#define XB_SPIN_CAP (1u << 18)

__device__ __forceinline__ unsigned xb_ld(unsigned* p)              { return __hip_atomic_load(p, __ATOMIC_RELAXED, __HIP_MEMORY_SCOPE_AGENT); }
__device__ __forceinline__ unsigned xb_add(unsigned* p, unsigned v) { return __hip_atomic_fetch_add(p, v, __ATOMIC_RELAXED, __HIP_MEMORY_SCOPE_AGENT); }
__device__ __forceinline__ unsigned xb_xcc_id() { return (unsigned)__builtin_amdgcn_s_getreg((3 << 11) | 20) & 0xFu; }
#define XB_SPIN(cond, bar) do { unsigned _sp = 0; while (cond) { __builtin_amdgcn_s_sleep(1); \
    if ((++_sp & 255u) == 0u) { if (xb_ld(&(bar)[XB_TMO])) break; if (_sp > XB_SPIN_CAP) { atomicAdd(&(bar)[XB_TMO], 1u); break; } } } } while (0)

struct XcdBarrier {
    unsigned* bar; unsigned x;
    volatile LAS unsigned* st;
};

__device__ __forceinline__ XcdBarrier xcd_barrier_post(unsigned* bar, volatile LAS unsigned* st) {
    XcdBarrier b; b.bar = bar; b.x = xb_xcc_id(); b.st = st;
    if (threadIdx.x == 0) (void)xb_add(&bar[XB_XCNT(b.x)], 1u);
    return b;
}
__device__ __forceinline__ void xcd_barrier_complete(unsigned* bar, unsigned x, unsigned& nloc, unsigned& nx) {
    const unsigned G = gridDim.x * gridDim.y * gridDim.z;
    unsigned sum, cnt, mine, sp = 0u;
    for (;;) {
        sum = 0u; cnt = 0u; mine = 0u;
#pragma unroll
        for (unsigned j = 0; j < 16; ++j) { const unsigned c = xb_ld(&bar[XB_XCNT(j)]); sum += c; cnt += (c > 0u) ? 1u : 0u; mine = (j == x) ? c : mine; }
        if (sum == G) break;
        __builtin_amdgcn_s_sleep(1);
        if ((++sp & 255u) == 0u) { if (xb_ld(&bar[XB_TMO])) break; if (sp > XB_SPIN_CAP) { atomicAdd(&bar[XB_TMO], 1u); break; } }
    }
    nloc = mine > 0u ? mine : 1u; nx = cnt > 0u ? cnt : 1u;
}

__device__ __forceinline__ void xcd_barrier(const XcdBarrier& b) {
    asm volatile("s_waitcnt vmcnt(0)" ::: "memory");
    __syncthreads();
    if (threadIdx.x == 0) {
        unsigned* bar = b.bar;
        __builtin_amdgcn_s_waitcnt(0);
        unsigned nloc = b.st[0], nx = b.st[1];
        if (nloc == 0u) { xcd_barrier_complete(bar, b.x, nloc, nx); b.st[0] = nloc; b.st[1] = nx; }
        const unsigned old = xb_add(&bar[XB_XSUB(b.x)], 1u);
        const unsigned gen = old / nloc;
        if (old + 1u == (gen + 1u) * nloc) {
            __builtin_amdgcn_fence(__ATOMIC_RELEASE, "agent");
            asm volatile("s_waitcnt vmcnt(0)" ::: "memory");
            const unsigned og = xb_add(&bar[XB_TOP], 1u);
            const unsigned tg = og / nx;
            if (og + 1u == (tg + 1u) * nx) xb_add(&bar[XB_TOPGEN], 1u);
            else XB_SPIN(xb_ld(&bar[XB_TOPGEN]) == tg, bar);
            __builtin_amdgcn_fence(__ATOMIC_ACQUIRE, "agent");
            xb_add(&bar[XB_XGEN(b.x)], 1u);
            asm volatile("s_waitcnt vmcnt(0)" ::: "memory");
        } else {
            XB_SPIN(xb_ld(&bar[XB_XGEN(b.x)]) == gen, bar);
            __builtin_amdgcn_fence(__ATOMIC_ACQUIRE, "agent");
            asm volatile("s_waitcnt vmcnt(0)" ::: "memory");
        }
    }
    __syncthreads();
}

constexpr int BATCH = 4, SEQ = 4096, DM = 4096, DEPTH = 4, M = BATCH * SEQ;
constexpr int NIN = 11264, LDP = NIN, KP = DM;
constexpr int C_AQ = 0, C_AK = 2048, C_AV = 2560, C_AG = 3072, C_RQ = 5120, C_RK = 6144, C_RV = 7168, C_RG = 9216;
constexpr int NHQ = 16, NHKV = 4, RH = 8, NCH = SEQ / 128;
constexpr float EPS = 1e-6f;
constexpr int NWAVES = 8;
#ifndef MK_PER_PHASE
#define MK_PER_PHASE 0
#endif
constexpr int NPH = 2 + 5 * DEPTH;
#ifndef PH_MASK
#define PH_MASK 0x3ff
#endif
#define PH_EN(k) ((PH_MASK >> (k)) & 1)
#ifndef DUP_MASK
#define DUP_MASK 0
#endif
#ifndef PP16
#define PP16 1
#endif
#ifndef PP_PRIO
#define PP_PRIO 0
#endif
#ifndef ATT_PROBE
#define ATT_PROBE 0
#endif
#ifndef PP_ROLE
#define PP_ROLE(w) ((w) >> 2)
#endif
#define DUP(k) (((DUP_MASK >> (k)) & 1) ? 2 : 1)

constexpr size_t MiB = 1u << 20;
constexpr size_t WS_CTL = 0, CTL_ZERO_BYTES = 1 * MiB;
constexpr size_t WS_ROPE = 1 * MiB;
constexpr size_t WS_WIN = 2 * MiB;
constexpr size_t WS_WOUT = WS_WIN + (size_t)DEPTH * NIN * KP * 2;
constexpr size_t WS_XCUR = WS_WOUT + (size_t)DEPTH * DM * KP * 2;
constexpr size_t WS_XN = WS_XCUR + (size_t)M * DM * 2;
constexpr int GP = 2048;
constexpr size_t WS_GA = WS_XN + (size_t)M * KP * 2;
constexpr size_t WS_RV = WS_GA + (size_t)M * GP * 2;
constexpr size_t WS_GR = WS_RV + (size_t)M * GP * 2;
constexpr size_t WS_SSQ = WS_GR + (size_t)M * GP * 2;
constexpr size_t WS_SSK = WS_SSQ + (size_t)M * 16 * 4 * 4;
constexpr size_t WS_MIX = WS_SSK + (size_t)M * 4 * 4 * 4;
constexpr size_t WS_FST = WS_MIX + (size_t)M * KP * 2;
constexpr size_t WS_QC = WS_FST + (size_t)2 * BATCH * RH * NCH * 128 * 256 * 2;
constexpr size_t WS_KC = WS_QC + (size_t)M * 2048 * 2;
constexpr size_t WS_VC = WS_KC + (size_t)M * 512 * 2;
constexpr size_t WS_RQC = WS_VC + (size_t)M * 512 * 2;
constexpr size_t WS_RKC = WS_RQC + (size_t)M * 1024 * 2;
constexpr size_t WS_END = WS_RKC + (size_t)M * 1024 * 2;
constexpr int CW_QUEUE = 8192;
constexpr int CW_BAR = 4096;

constexpr int RING_BYTES = 131072;
constexpr int LDSCTL_OFF = RING_BYTES, MISC_OFF = LDSCTL_OFF + 320;
constexpr int ROPE_LDS = RING_BYTES + 1024, GAIN_LDS = ROPE_LDS + 16384;
constexpr int RSTD_LDS = GAIN_LDS + 1024;
constexpr int LDS_BYTES = RSTD_LDS + 8192;

typedef short s16x4 __attribute__((ext_vector_type(4)));
typedef float f32x16 __attribute__((ext_vector_type(16)));
typedef unsigned u32x4 __attribute__((ext_vector_type(4)));
#define SBAR() __builtin_amdgcn_sched_barrier(0)

__device__ __forceinline__ float bf2f(unsigned short x) { return __uint_as_float((unsigned)x << 16); }
typedef float f32x2_t __attribute__((ext_vector_type(2))); typedef __bf16 bf16x2_t __attribute__((ext_vector_type(2)));
__device__ __forceinline__ unsigned cvtpk(float lo, float hi) { f32x2_t v = {lo, hi}; bf16x2_t r = __builtin_convertvector(v, bf16x2_t); return __builtin_bit_cast(unsigned, r); }
__device__ __forceinline__ unsigned short f2bf1(float x) { return (unsigned short)(cvtpk(x, x) & 0xffffu); }
__device__ __forceinline__ bf16x8 ld8(const bf16* p) { return *reinterpret_cast<const bf16x8*>(p); }
__device__ __forceinline__ void unpack8(bf16x8 v, float* f) {
    const u32x4 w = __builtin_bit_cast(u32x4, v);
#pragma unroll
    for (int i = 0; i < 4; ++i) { f[2 * i] = __uint_as_float(w[i] << 16); f[2 * i + 1] = __uint_as_float(w[i] & 0xffff0000u); }
}
__device__ __forceinline__ bf16x8 pack8(const float* f) {
    u32x4 w; w.x = cvtpk(f[0], f[1]); w.y = cvtpk(f[2], f[3]); w.z = cvtpk(f[4], f[5]); w.w = cvtpk(f[6], f[7]); return __builtin_bit_cast(bf16x8, w);
}
__device__ __forceinline__ bf16x8 scale8(bf16x8 v, float s) { float f[8]; unpack8(v, f);
#pragma unroll
    for (int i = 0; i < 8; ++i) f[i] *= s;
    return pack8(f); }
__device__ __forceinline__ float silu_f(float x) { return x * __builtin_amdgcn_rcpf(1.0f + __builtin_amdgcn_exp2f(-1.4426950408889634f * x)); }
#define DPPF(x, ctrl) __uint_as_float((unsigned)__builtin_amdgcn_update_dpp(0, (int)__float_as_uint(x), ctrl, 0xf, 0xf, true))
__device__ __forceinline__ float xsum2(float v)  { return v + DPPF(v, 0xB1); }
__device__ __forceinline__ float xsum4(float v)  { v = xsum2(v); return v + DPPF(v, 0x4E); }
__device__ __forceinline__ float xsum8(float v)  { v = xsum4(v); return v + DPPF(v, 0x141); }
__device__ __forceinline__ float xsum16(float v) { v = xsum8(v); return v + DPPF(v, 0x140); }
__device__ __forceinline__ float xsum32(float v) { v = xsum16(v); auto r = __builtin_amdgcn_permlane16_swap(__float_as_uint(v), __float_as_uint(v), false, false); return __uint_as_float(r[0]) + __uint_as_float(r[1]); }
__device__ __forceinline__ float wave_sum(float v) { v = xsum32(v); auto r = __builtin_amdgcn_permlane32_swap(__float_as_uint(v), __float_as_uint(v), false, false); return __uint_as_float(r[0]) + __uint_as_float(r[1]); }
__device__ __forceinline__ float wave_max(float v) {
    v = fmaxf(v, DPPF(v, 0xB1)); v = fmaxf(v, DPPF(v, 0x4E)); v = fmaxf(v, DPPF(v, 0x141)); v = fmaxf(v, DPPF(v, 0x140));
    { auto r = __builtin_amdgcn_permlane16_swap(__float_as_uint(v), __float_as_uint(v), false, false); v = fmaxf(__uint_as_float(r[0]), __uint_as_float(r[1])); }
    { auto r = __builtin_amdgcn_permlane32_swap(__float_as_uint(v), __float_as_uint(v), false, false); v = fmaxf(__uint_as_float(r[0]), __uint_as_float(r[1])); }
    return v;
}
__device__ __forceinline__ float log2_sigmoid(float x) {
    const float y = expf(-x); float l;
    if (y < 0.25f) { const float y2 = y * y; l = y * (1.f + y * (-0.5f + y * (1.f / 3.f + y * (-0.25f + y * (0.2f + y * (-1.f / 6.f + y * (1.f / 7.f + y * (-0.125f + y * (1.f / 9.f))))))))); (void)y2; }
    else l = logf(1.f + y);
    return -l * 1.4426950408889634f;
}

#define KSWZ(row, colB) ((row) * 256 + ((colB) ^ (((row) & 7) << 4)))
__device__ __forceinline__ int crow(int r, int hi) { return (r & 3) + 8 * (r >> 2) + 4 * hi; }
constexpr float ATT_SCALE = 0.088388347648318440f;
constexpr float ATT_THR = 8.f;
__device__ __forceinline__ void partialSM(f32x16& p0, f32x16& p1, float& m_reg, float& mn, float& alpha, const float C  ) {
  float pmax = p0[0];
#pragma unroll
  for (int r = 1; r < 16; ++r) pmax = fmaxf(pmax, p0[r]);
#pragma unroll
  for (int r = 0; r < 16; ++r) pmax = fmaxf(pmax, p1[r]);
  { auto rr = __builtin_amdgcn_permlane32_swap(__float_as_uint(pmax), __float_as_uint(pmax), false, false);
    pmax = fmaxf(__uint_as_float(rr[0]), __uint_as_float(rr[1])); }
  if (__builtin_expect(__all((pmax - m_reg) * C <= ATT_THR * 1.4426950408889634f), 1)) { mn = m_reg; alpha = 1.f; }
  else { mn = fmaxf(m_reg, pmax); alpha = __builtin_amdgcn_exp2f((m_reg - mn) * C); m_reg = mn; }
  float mnC = -mn * C;
#pragma unroll
  for (int r = 0; r < 16; ++r) p0[r] = fmaf(p0[r], C, mnC);
#pragma unroll
  for (int r = 0; r < 16; ++r) p1[r] = fmaf(p1[r], C, mnC);
#pragma unroll
  for (int r = 0; r < 16; ++r) p0[r] = __builtin_amdgcn_exp2f(p0[r]);
}
#define PK4(P, BASE, OUT) do { unsigned a0 = cvtpk(P[BASE + 0], P[BASE + 1]), a1 = cvtpk(P[BASE + 2], P[BASE + 3]);   \
    unsigned b0 = cvtpk(P[BASE + 4], P[BASE + 5]), b1 = cvtpk(P[BASE + 6], P[BASE + 7]);                              \
    auto r0 = __builtin_amdgcn_permlane32_swap(a0, b0, false, false); auto r1 = __builtin_amdgcn_permlane32_swap(a1, b1, false, false); \
    u32x4 w = {r0[0], r1[0], r0[1], r1[1]}; OUT = *reinterpret_cast<bf16x8*>(&w); } while (0)
__device__ __forceinline__ void finishSM(f32x16& p0, f32x16& p1, float alpha, float& l_reg, bf16x8& pa0, bf16x8& pa1, bf16x8& pa2, bf16x8& pa3) {
#pragma unroll
  for (int r = 0; r < 16; ++r) p1[r] = __builtin_amdgcn_exp2f(p1[r]);
  float ps = 0;
#pragma unroll
  for (int r = 0; r < 16; ++r) ps += p0[r];
#pragma unroll
  for (int r = 0; r < 16; ++r) ps += p1[r];
  { auto rr = __builtin_amdgcn_permlane32_swap(__float_as_uint(ps), __float_as_uint(ps), false, false);
    ps = __uint_as_float(rr[0]) + __uint_as_float(rr[1]); }
  l_reg = l_reg * alpha + ps;
  PK4(p0, 0, pa0); PK4(p0, 8, pa1); PK4(p1, 0, pa2); PK4(p1, 8, pa3);
}
__device__ __forceinline__ void qkt(f32x16& p0, f32x16& p1, const char* Ks, const bf16x8* qr, int r32, int hi) {
  p0 = f32x16{}; p1 = f32x16{};
#pragma unroll
  for (int d0 = 0; d0 < 8; ++d0) { int cb = (d0 * 16 + hi * 8) * 2;
    bf16x8 b0 = *reinterpret_cast<const bf16x8*>(Ks + KSWZ(r32, cb));
    bf16x8 b1 = *reinterpret_cast<const bf16x8*>(Ks + KSWZ(32 + r32, cb));
    p0 = __builtin_amdgcn_mfma_f32_32x32x16_bf16(b0, qr[d0], p0, 0, 0, 0);
    p1 = __builtin_amdgcn_mfma_f32_32x32x16_bf16(b1, qr[d0], p1, 0, 0, 0); }
}
__device__ __forceinline__ int v_st(int k, int c) { const int kk = (k & ~0xC) | ((k & 4) << 1) | ((k & 8) >> 1); return ((kk >> 3) * 4 + (c >> 5)) * 512 + ((kk & 7) * 32 + (c & 31)) * 2; }
__device__ __forceinline__ int v_rd_base(int lane) { return ((lane & 3) << 3) | (((lane >> 2) & 3) << 6) | (((lane >> 4) & 1) << 5) | (((lane >> 5) & 1) << 8); }
constexpr int v_rd_off(int d0, int ks, int half) { return d0 * 512 + ks * 4096 + half * 2048; }
template <int OFF> __device__ __forceinline__ s16x4 tr_read(int vb) {
  s16x4 r; asm volatile("ds_read_b64_tr_b16 %0, %1 offset:%2" : "=&v"(r) : "v"(vb), "i"(OFF) : "memory"); return r;
}
#define PKV(L, H) (bf16x8){L[0], L[1], L[2], L[3], H[0], H[1], H[2], H[3]}
template <int D0> __device__ __forceinline__ void pv_one(f32x16& od, int vb, bf16x8 pa0, bf16x8 pa1, bf16x8 pa2, bf16x8 pa3) {
  const s16x4 l0 = tr_read<v_rd_off(D0, 0, 0)>(vb), h0 = tr_read<v_rd_off(D0, 0, 1)>(vb), l1 = tr_read<v_rd_off(D0, 1, 0)>(vb), h1 = tr_read<v_rd_off(D0, 1, 1)>(vb);
  const s16x4 l2 = tr_read<v_rd_off(D0, 2, 0)>(vb), h2 = tr_read<v_rd_off(D0, 2, 1)>(vb), l3 = tr_read<v_rd_off(D0, 3, 0)>(vb), h3 = tr_read<v_rd_off(D0, 3, 1)>(vb);
  asm volatile("s_waitcnt lgkmcnt(0)" ::: "memory"); SBAR();
  od = __builtin_amdgcn_mfma_f32_32x32x16_bf16(pa0, PKV(l0, h0), od, 0, 0, 0);
  od = __builtin_amdgcn_mfma_f32_32x32x16_bf16(pa1, PKV(l1, h1), od, 0, 0, 0);
  od = __builtin_amdgcn_mfma_f32_32x32x16_bf16(pa2, PKV(l2, h2), od, 0, 0, 0);
  od = __builtin_amdgcn_mfma_f32_32x32x16_bf16(pa3, PKV(l3, h3), od, 0, 0, 0);
}
__device__ __forceinline__ void pv_d0(f32x16* o, int vb, bf16x8 pa0, bf16x8 pa1, bf16x8 pa2, bf16x8 pa3) {
  pv_one<0>(o[0], vb, pa0, pa1, pa2, pa3); pv_one<1>(o[1], vb, pa0, pa1, pa2, pa3); pv_one<2>(o[2], vb, pa0, pa1, pa2, pa3); pv_one<3>(o[3], vb, pa0, pa1, pa2, pa3);
}

constexpr int SHM_V = 64 * 128 * 2, SHM_K = 64 * 128 * 2;
__device__ __forceinline__ void attn_unit(const bf16* __restrict__ Qb, const bf16* __restrict__ Kh, const bf16* __restrict__ Vh, const bf16* __restrict__ Gb, const float* __restrict__ ssq  , bf16* __restrict__ Ob, char* lds) {
  int tid = threadIdx.x; asm volatile("" : "+v"(tid));
  const int wid = tid >> 6, lane = tid & 63, r32 = lane & 31, hi = lane >> 5;
  char* V_lds = lds; char* K_lds = lds + 2 * SHM_V;
  float* ws = (float*)(lds + 2 * SHM_V + 2 * SHM_K) + wid * 64; float* li_l = ws; float* al_l = ws + 32;
  float m_reg = -1e30f, l_reg = 0; f32x16 o[4] = {}; bf16x8 qr[8];
  const bf16* Qw = Qb + (size_t)(wid * 32 + r32) * 128 + hi * 8;
#pragma unroll
  for (int d0 = 0; d0 < 8; ++d0) qr[d0] = ld8(Qw + d0 * 16);
  float Cq; { const f32x4 pq = *(const f32x4*)(ssq + (size_t)(wid * 32 + r32) * 64); Cq = ATT_SCALE * 1.4426950408889634f / sqrtf(((pq.x + pq.y) + (pq.z + pq.w)) * (1.f / 128.f) + EPS); }
  const int sr = tid >> 4, sc = (tid & 15) * 8, vst0 = v_st(sr, sc), vst1 = v_st(32 + sr, sc);
  const int vb0 = (int)(uintptr_t)V_lds + v_rd_base(lane);
  struct { bf16x8 vs0, vs1, ks0, ks1; } sr_[2];
#define SLOAD(i, k0) do { sr_[i].vs0 = ld8(&Vh[(size_t)((k0) + sr) * 128 + sc]); sr_[i].vs1 = ld8(&Vh[(size_t)((k0) + 32 + sr) * 128 + sc]); \
    sr_[i].ks0 = ld8(&Kh[(size_t)((k0) + sr) * 128 + sc]); sr_[i].ks1 = ld8(&Kh[(size_t)((k0) + 32 + sr) * 128 + sc]); } while (0)
#define SWRITE(b, i) do { *(bf16x8*)(V_lds + (b) * SHM_V + vst0) = sr_[i].vs0;          \
    *(bf16x8*)(V_lds + (b) * SHM_V + vst1) = sr_[i].vs1; int kc = sc * 2;               \
    *(bf16x8*)(K_lds + (b) * SHM_K + KSWZ(sr, kc)) = sr_[i].ks0;                       \
    *(bf16x8*)(K_lds + (b) * SHM_K + KSWZ(32 + sr, kc)) = sr_[i].ks1; } while (0)
#define SWAIT() asm volatile("s_waitcnt vmcnt(4)" ::: "memory")
#define RESC(a) do { if (__any((a) < 1.f)) { if (hi == 0) al_l[r32] = (a); asm volatile("s_waitcnt lgkmcnt(0)" ::: "memory"); \
    _Pragma("unroll") for (int d = 0; d < 4; ++d) _Pragma("unroll") for (int r = 0; r < 16; ++r) o[d][r] *= al_l[crow(r, hi)]; } } while (0)
  f32x16 pA0, pA1, pB0, pB1; float mnA, mnB, alA, alB; bf16x8 pa0, pa1, pa2, pa3; constexpr int NT = SEQ / 64;
  SLOAD(0, 0); asm volatile("s_waitcnt vmcnt(0)" ::: "memory"); SWRITE(0, 0); __syncthreads();
  qkt(pA0, pA1, K_lds, qr, r32, hi); partialSM(pA0, pA1, m_reg, mnA, alA, Cq);
  SLOAD(1, 64); SLOAD(0, 128);
  SWAIT(); SWRITE(1, 1); __syncthreads();
  for (int j = 1; j + 1 < NT; j += 2) {
    SBAR(); qkt(pB0, pB1, K_lds + SHM_K, qr, r32, hi);
    finishSM(pA0, pA1, alA, l_reg, pa0, pa1, pa2, pa3); SBAR();
    SLOAD(1, (j + 2) * 64); SBAR();
    pv_d0(o, vb0, pa0, pa1, pa2, pa3); partialSM(pB0, pB1, m_reg, mnB, alB, Cq);
    __syncthreads(); SWAIT(); SWRITE(0, 0);
    RESC(alB); __syncthreads();
    SBAR(); qkt(pA0, pA1, K_lds, qr, r32, hi);
    finishSM(pB0, pB1, alB, l_reg, pa0, pa1, pa2, pa3); SBAR();
    if (j + 3 < NT) SLOAD(0, (j + 3) * 64); SBAR();
    pv_d0(o, vb0 + SHM_V, pa0, pa1, pa2, pa3); partialSM(pA0, pA1, m_reg, mnA, alA, Cq);
    __syncthreads(); SWAIT(); SWRITE(1, 1);
    RESC(alA); __syncthreads();
  }
  SBAR(); qkt(pB0, pB1, K_lds + SHM_K, qr, r32, hi);
  finishSM(pA0, pA1, alA, l_reg, pa0, pa1, pa2, pa3); SBAR();
  pv_d0(o, vb0, pa0, pa1, pa2, pa3); partialSM(pB0, pB1, m_reg, mnB, alB, Cq);
  __syncthreads(); RESC(alB);
  finishSM(pB0, pB1, alB, l_reg, pa0, pa1, pa2, pa3); SBAR();
  pv_d0(o, vb0 + SHM_V, pa0, pa1, pa2, pa3);
  if (hi == 0) li_l[r32] = l_reg; asm volatile("s_waitcnt lgkmcnt(0)" ::: "memory");
  float rli[16];
#pragma unroll
  for (int r = 0; r < 16; ++r) rli[r] = __builtin_amdgcn_rcpf(li_l[crow(r, hi)]);
  __syncthreads();
  { unsigned short* stg = (unsigned short*)(lds + wid * 8192);
#pragma unroll
    for (int r = 0; r < 16; ++r) { const int orow = crow(r, hi);
#pragma unroll
      for (int d0 = 0; d0 < 4; ++d0) stg[orow * 128 + d0 * 32 + r32] = f2bf1(o[d0][r] * rli[r]); }
    asm volatile("s_waitcnt lgkmcnt(0)" ::: "memory");
    const int er = lane >> 4, ec = (lane & 15) * 8;
    const bf16* Gw = Gb + (size_t)(wid * 32 + er) * 128 + ec; bf16* Ow = Ob + (size_t)(wid * 32 + er) * KP + ec;
#pragma unroll
    for (int i = 0; i < 8; ++i) { float ov[8], gv[8]; unpack8(*(const bf16x8*)(stg + (i * 4 + er) * 128 + ec), ov); unpack8(ld8(Gw + (size_t)(i * 4) * 128), gv);
#pragma unroll
      for (int e = 0; e < 8; ++e) ov[e] *= silu_f(gv[e]);
      *(bf16x8*)(Ow + (size_t)(i * 4) * KP) = pack8(ov); asm volatile("" ::: "memory"); } }
  __syncthreads();
#undef SLOAD
#undef SWRITE
#undef SWAIT
#undef RESC
}

#define PKN(P, BASE, OUT) do { u32x4 w_ = {cvtpk(P[BASE + 0], P[BASE + 1]), cvtpk(P[BASE + 2], P[BASE + 3]), cvtpk(P[BASE + 4], P[BASE + 5]), cvtpk(P[BASE + 6], P[BASE + 7])}; OUT = *reinterpret_cast<bf16x8*>(&w_); } while (0)
__device__ __forceinline__ void finishSM_n(f32x16& p0, f32x16& p1, float alpha, float& l_reg, bf16x8& pa0, bf16x8& pa1, bf16x8& pa2, bf16x8& pa3) {
#pragma unroll
  for (int r = 0; r < 16; ++r) p1[r] = __builtin_amdgcn_exp2f(p1[r]);
  float ps = 0;
#pragma unroll
  for (int r = 0; r < 16; ++r) ps += p0[r];
#pragma unroll
  for (int r = 0; r < 16; ++r) ps += p1[r];
  { auto rr = __builtin_amdgcn_permlane32_swap(__float_as_uint(ps), __float_as_uint(ps), false, false);
    ps = __uint_as_float(rr[0]) + __uint_as_float(rr[1]); }
  l_reg = l_reg * alpha + ps;
  PKN(p0, 0, pa0); PKN(p0, 8, pa1); PKN(p1, 0, pa2); PKN(p1, 8, pa3);
}
__device__ __forceinline__ void pp_softmax_nomax(f32x16& p0, f32x16& p1, float& l_reg, bf16x8& pa0, bf16x8& pa1, bf16x8& pa2, bf16x8& pa3) {
#pragma unroll
  for (int r = 0; r < 16; ++r) p0[r] = __builtin_amdgcn_exp2f(p0[r]);
#pragma unroll
  for (int r = 0; r < 16; ++r) p1[r] = __builtin_amdgcn_exp2f(p1[r]);
  float ps = 0;
#pragma unroll
  for (int r = 0; r < 16; ++r) ps += p0[r];
#pragma unroll
  for (int r = 0; r < 16; ++r) ps += p1[r];
  { auto rr = __builtin_amdgcn_permlane32_swap(__float_as_uint(ps), __float_as_uint(ps), false, false);
    ps = __uint_as_float(rr[0]) + __uint_as_float(rr[1]); }
  l_reg += ps;
  PKN(p0, 0, pa0); PKN(p0, 8, pa1); PKN(p1, 0, pa2); PKN(p1, 8, pa3);
}
template <int OFF> __device__ __forceinline__ bf16x8 k_read(int a) { bf16x8 r; asm volatile("ds_read_b128 %0, %1 offset:%2" : "=&v"(r) : "v"(a), "i"(OFF) : "memory"); return r; }
#define PPW2(n, a, b) asm volatile("s_waitcnt lgkmcnt(" #n ")" : "+v"(a), "+v"(b) :: "memory")
#define PPW4(n, a, b, c, d) asm volatile("s_waitcnt lgkmcnt(" #n ")" : "+v"(a), "+v"(b), "+v"(c), "+v"(d) :: "memory")
template <bool HASPV, bool DUPM = false, int KS = 0  , int VS = 0  > __device__ __forceinline__ void pp_mma(f32x16& p0, f32x16& p1, f32x16* o, const bf16x8* qr, bf16x8 pa0, bf16x8 pa1, bf16x8 pa2, bf16x8 pa3, int kA0, int kA1, int kA2, int kA3, int vb) {
#define KR0(d0) k_read<((d0) >> 2) * 128 + KS>(((d0) & 3) == 0 ? kA0 : ((d0) & 3) == 1 ? kA1 : ((d0) & 3) == 2 ? kA2 : kA3)
#define KR1(d0) k_read<((d0) >> 2) * 128 + 8192 + KS>(((d0) & 3) == 0 ? kA0 : ((d0) & 3) == 1 ? kA1 : ((d0) & 3) == 2 ? kA2 : kA3)
#define HRD(u, la, ha, lb, hb) s16x4 la = tr_read<v_rd_off(2 * ((u) & 1), (u) >> 1, 0) + VS>(vb), ha = tr_read<v_rd_off(2 * ((u) & 1), (u) >> 1, 1) + VS>(vb), lb = tr_read<v_rd_off(2 * ((u) & 1) + 1, (u) >> 1, 0) + VS>(vb), hb = tr_read<v_rd_off(2 * ((u) & 1) + 1, (u) >> 1, 1) + VS>(vb)
#define KMM(d0, a, b) do { p0 = __builtin_amdgcn_mfma_f32_32x32x16_bf16(a, qr[d0], p0, 0, 0, 0); p1 = __builtin_amdgcn_mfma_f32_32x32x16_bf16(b, qr[d0], p1, 0, 0, 0); if constexpr (DUPM) { p0 = __builtin_amdgcn_mfma_f32_32x32x16_bf16(b, qr[d0], p0, 0, 0, 0); p1 = __builtin_amdgcn_mfma_f32_32x32x16_bf16(a, qr[d0], p1, 0, 0, 0); } } while (0)
#define HMM(u, pa, la, ha, lb, hb) do { o[2 * ((u) & 1)] = __builtin_amdgcn_mfma_f32_32x32x16_bf16(pa, PKV(la, ha), o[2 * ((u) & 1)], 0, 0, 0); o[2 * ((u) & 1) + 1] = __builtin_amdgcn_mfma_f32_32x32x16_bf16(pa, PKV(lb, hb), o[2 * ((u) & 1) + 1], 0, 0, 0); } while (0)
  p0 = f32x16{}; p1 = f32x16{};
  bf16x8 a0 = KR0(0), b0 = KR1(0), a1 = KR0(1), b1 = KR1(1), a2 = KR0(2), b2 = KR1(2), a3 = KR0(3), b3 = KR1(3);
  PPW2(6, a0, b0); KMM(0, a0, b0); bf16x8 a4 = KR0(4), b4 = KR1(4);
  PPW2(6, a1, b1); KMM(1, a1, b1); bf16x8 a5 = KR0(5), b5 = KR1(5);
  PPW2(6, a2, b2); KMM(2, a2, b2); bf16x8 a6 = KR0(6), b6 = KR1(6);
  PPW2(6, a3, b3); KMM(3, a3, b3); bf16x8 a7 = KR0(7), b7 = KR1(7);
  if constexpr (HASPV) {
    PPW2(6, a4, b4); KMM(4, a4, b4); HRD(0, l0a, h0a, l0b, h0b);
    PPW2(8, a5, b5); KMM(5, a5, b5); HRD(1, l1a, h1a, l1b, h1b);
    PPW2(10, a6, b6); KMM(6, a6, b6); HRD(2, l2a, h2a, l2b, h2b);
    PPW2(12, a7, b7); KMM(7, a7, b7);
    PPW4(8, l0a, h0a, l0b, h0b); HMM(0, pa0, l0a, h0a, l0b, h0b); HRD(3, l3a, h3a, l3b, h3b);
    PPW4(8, l1a, h1a, l1b, h1b); HMM(1, pa0, l1a, h1a, l1b, h1b); HRD(4, l4a, h4a, l4b, h4b);
    PPW4(8, l2a, h2a, l2b, h2b); HMM(2, pa1, l2a, h2a, l2b, h2b); HRD(5, l5a, h5a, l5b, h5b);
    PPW4(8, l3a, h3a, l3b, h3b); HMM(3, pa1, l3a, h3a, l3b, h3b); HRD(6, l6a, h6a, l6b, h6b);
    PPW4(8, l4a, h4a, l4b, h4b); HMM(4, pa2, l4a, h4a, l4b, h4b); HRD(7, l7a, h7a, l7b, h7b);
    PPW4(8, l5a, h5a, l5b, h5b); HMM(5, pa2, l5a, h5a, l5b, h5b);
    PPW4(4, l6a, h6a, l6b, h6b); HMM(6, pa3, l6a, h6a, l6b, h6b);
    PPW4(0, l7a, h7a, l7b, h7b); HMM(7, pa3, l7a, h7a, l7b, h7b);
  } else {
    PPW2(6, a4, b4); KMM(4, a4, b4);
    PPW2(4, a5, b5); KMM(5, a5, b5);
    PPW2(2, a6, b6); KMM(6, a6, b6);
    PPW2(0, a7, b7); KMM(7, a7, b7);
  }
#undef KR0
#undef KR1
#undef HRD
#undef KMM
#undef HMM
}
__device__ __forceinline__ void pp_pv_tail(f32x16* o, bf16x8 pa0, bf16x8 pa1, bf16x8 pa2, bf16x8 pa3, int vb) {
#define HRD(u, la, ha, lb, hb) s16x4 la = tr_read<v_rd_off(2 * ((u) & 1), (u) >> 1, 0)>(vb), ha = tr_read<v_rd_off(2 * ((u) & 1), (u) >> 1, 1)>(vb), lb = tr_read<v_rd_off(2 * ((u) & 1) + 1, (u) >> 1, 0)>(vb), hb = tr_read<v_rd_off(2 * ((u) & 1) + 1, (u) >> 1, 1)>(vb)
#define HMM(u, pa, la, ha, lb, hb) do { o[2 * ((u) & 1)] = __builtin_amdgcn_mfma_f32_32x32x16_bf16(pa, PKV(la, ha), o[2 * ((u) & 1)], 0, 0, 0); o[2 * ((u) & 1) + 1] = __builtin_amdgcn_mfma_f32_32x32x16_bf16(pa, PKV(lb, hb), o[2 * ((u) & 1) + 1], 0, 0, 0); } while (0)
  HRD(0, l0a, h0a, l0b, h0b); HRD(1, l1a, h1a, l1b, h1b); HRD(2, l2a, h2a, l2b, h2b);
  PPW4(8, l0a, h0a, l0b, h0b); HMM(0, pa0, l0a, h0a, l0b, h0b); HRD(3, l3a, h3a, l3b, h3b);
  PPW4(8, l1a, h1a, l1b, h1b); HMM(1, pa0, l1a, h1a, l1b, h1b); HRD(4, l4a, h4a, l4b, h4b);
  PPW4(8, l2a, h2a, l2b, h2b); HMM(2, pa1, l2a, h2a, l2b, h2b); HRD(5, l5a, h5a, l5b, h5b);
  PPW4(8, l3a, h3a, l3b, h3b); HMM(3, pa1, l3a, h3a, l3b, h3b); HRD(6, l6a, h6a, l6b, h6b);
  PPW4(8, l4a, h4a, l4b, h4b); HMM(4, pa2, l4a, h4a, l4b, h4b); HRD(7, l7a, h7a, l7b, h7b);
  PPW4(8, l5a, h5a, l5b, h5b); HMM(5, pa2, l5a, h5a, l5b, h5b);
  PPW4(4, l6a, h6a, l6b, h6b); HMM(6, pa3, l6a, h6a, l6b, h6b);
  PPW4(0, l7a, h7a, l7b, h7b); HMM(7, pa3, l7a, h7a, l7b, h7b);
#undef HRD
#undef HMM
}
template <int MODE  , bool NOMAX  > __device__ __forceinline__ void attn_unit_pp(const bf16* __restrict__ Qb, const bf16* __restrict__ Kh, const bf16* __restrict__ Vh, const bf16* __restrict__ Gb, const float* __restrict__ ssq, bf16* __restrict__ Ob, char* lds, LAS unsigned char* ldsl) {
  int tid = threadIdx.x; asm volatile("" : "+v"(tid));
  const int wid = __builtin_amdgcn_readfirstlane(tid >> 6), lane = tid & 63, r32 = lane & 31, hi = lane >> 5, role = PP_ROLE(wid);
  char* V_lds = lds; char* K_lds = lds + 3 * SHM_V;
  LAS float* ws = (LAS float*)(ldsl + 3 * SHM_V + 3 * SHM_K) + wid * 64; LAS float* li_l = ws; LAS float* al_l = ws + 32;
  unsigned koff[2], voff[2];
#pragma unroll
  for (int i = 0; i < 2; ++i) { const int blk = 2 * wid + i;
    { const int row = 4 * blk + (lane >> 4), chunk = (lane & 15) ^ (row & 7); koff[i] = (unsigned)(row * 128 + chunk * 8) * 2u; }
    { const int st = 2 * blk + (lane >> 5), k = (st >> 2) * 8 + ((lane & 31) >> 2); voff[i] = (unsigned)(k * 128 + (st & 3) * 32 + (lane & 3) * 8) * 2u; } }
#define PP_SLOT(t) (((t) - 3 * (((t) * 43) >> 7)) * SHM_V)
  const unsigned ldsb_ = (unsigned)(size_t)ldsl;
  const __amdgpu_buffer_rsrc_t srdK_ = __builtin_amdgcn_make_buffer_rsrc((void*)Kh, (short)0, SEQ * 128 * 2, 0x00020000), srdV_ = __builtin_amdgcn_make_buffer_rsrc((void*)Vh, (short)0, SEQ * 128 * 2, 0x00020000);
#define PP_DMA_K(t) do { const unsigned so_ = (unsigned)PP_SLOT(t), tb_ = (unsigned)(t) * (64u * 128u * 2u); _Pragma("unroll") for (int i_ = 0; i_ < 2; ++i_) \
    asm volatile("s_nop 4\n\ts_mov_b32 m0, %0\n\ts_nop 0\n\tbuffer_load_dwordx4 %1, %2, %3 offen lds" :: "s"(ldsb_ + 3u * SHM_V + so_ + (unsigned)(2 * wid + i_) * 1024u), "v"(koff[i_]), "s"(srdK_), "s"(tb_) : "m0", "memory"); } while (0)
#define PP_DMA_V(t) do { const unsigned so_ = (unsigned)PP_SLOT(t), tb_ = (unsigned)(t) * (64u * 128u * 2u); _Pragma("unroll") for (int i_ = 0; i_ < 2; ++i_) \
    asm volatile("s_nop 4\n\ts_mov_b32 m0, %0\n\ts_nop 0\n\tbuffer_load_dwordx4 %1, %2, %3 offen lds" :: "s"(ldsb_ + so_ + (unsigned)(2 * wid + i_) * 1024u), "v"(voff[i_]), "s"(srdV_), "s"(tb_) : "m0", "memory"); } while (0)
#define PP_ISSUE(t) do { if ((t) + 2 < NT) PP_DMA_K((t) + 2); if ((t) + 1 < NT) PP_DMA_V((t) + 1); } while (0)
#define PP_WAITL(t) do { if ((t) + 2 < NT) asm volatile("s_waitcnt vmcnt(4)" ::: "memory"); else if ((t) + 1 < NT) asm volatile("s_waitcnt vmcnt(2)" ::: "memory"); else asm volatile("s_waitcnt vmcnt(0)" ::: "memory"); } while (0)
#define PP_BAR() do { SBAR(); asm volatile("" ::: "memory"); __builtin_amdgcn_s_barrier(); asm volatile("" ::: "memory"); SBAR(); } while (0)
#define RESC(a) do { if (__any((a) < 1.f)) { if (hi == 0) al_l[r32] = (a); asm volatile("s_waitcnt lgkmcnt(0)" ::: "memory"); \
    _Pragma("unroll") for (int d = 0; d < 4; ++d) _Pragma("unroll") for (int r = 0; r < 16; ++r) o[d][r] *= al_l[crow(r, hi)]; } } while (0)
  constexpr int NT = SEQ / 64; static_assert((NT - 1) % 3 == 0, "the tile loop is unrolled by the ring period after the peeled tile 0");
  PP_DMA_K(0); PP_DMA_K(1); PP_DMA_V(0);
  float m_reg = -1e30f, l_reg = 0; f32x16 o[4] = {}; bf16x8 qr[8];
  const bf16* Qw = Qb + (size_t)(wid * 32 + r32) * 128 + hi * 8;
#pragma unroll
  for (int d0 = 0; d0 < 8; ++d0) qr[d0] = ld8(Qw + d0 * 16);
  float Cq; { const f32x4 pq = *(const f32x4*)(ssq + (size_t)(wid * 32 + r32) * 64); Cq = ATT_SCALE * 1.4426950408889634f / sqrtf(((pq.x + pq.y) + (pq.z + pq.w)) * (1.f / 128.f) + EPS); }
  const int vb0 = (int)(uintptr_t)V_lds + v_rd_base(lane);
  int kb[4];
  { const int c = ((r32 & 7) ^ hi) * 16, e = c >> 5;
#pragma unroll
    for (int k = 0; k < 4; ++k) kb[k] = (int)(uintptr_t)K_lds + r32 * 256 + (c & 16) + ((k ^ e) * 32); }
  f32x16 S0 = {}, S1 = {}; float mn, al; bf16x8 pa0 = {}, pa1 = {}, pa2 = {}, pa3 = {};
  asm volatile("s_waitcnt vmcnt(0) lgkmcnt(0)" ::: "memory");
  if constexpr (NOMAX) {
#pragma unroll
    for (int d0 = 0; d0 < 8; ++d0) qr[d0] = scale8(qr[d0], Cq); }
#pragma unroll
  for (int d0 = 0; d0 < 8; ++d0) asm volatile("" : "+v"(qr[d0]));
  asm volatile("" : "+v"(Cq));
  PP_BAR();
#define PP_SOFTMAX() do { if (MODE == 5 && role) { } else if constexpr (MODE == 0 || MODE == 2 || MODE == 5) { if constexpr (MODE == 2) { asm volatile("" : "+v"(S0), "+v"(S1)); } if constexpr (NOMAX) { pp_softmax_nomax(S0, S1, l_reg, pa0, pa1, pa2, pa3); } else { partialSM(S0, S1, m_reg, mn, al, Cq); finishSM_n(S0, S1, al, l_reg, pa0, pa1, pa2, pa3); RESC(al); } if constexpr (MODE == 2) { asm volatile("" :: "v"(pa0), "v"(pa1), "v"(pa2), "v"(pa3)); } } else { asm volatile("" :: "v"(S0), "v"(S1)); asm volatile("" : "+v"(pa0), "+v"(pa1), "+v"(pa2), "+v"(pa3)); } } while (0)
#define PP_MMA3(KSL, VSL) do { if (MODE == 5 && role) { } else if constexpr (MODE == 0 || MODE == 1 || MODE == 4 || MODE == 5) { pp_mma<true, MODE == 4, (KSL) * SHM_K, (VSL) * SHM_V>(S0, S1, o, qr, pa0, pa1, pa2, pa3, kb[0], kb[1], kb[2], kb[3], vb0); } } while (0)
  if (PP_PRIO && role) __builtin_amdgcn_s_setprio(PP_PRIO);
  if (role == 0) {
    pp_mma<false>(S0, S1, o, qr, pa0, pa1, pa2, pa3, kb[0], kb[1], kb[2], kb[3], vb0); SBAR(); PP_ISSUE(0); PP_SOFTMAX(); PP_WAITL(0); PP_BAR();
#pragma unroll 1
    for (int j = 1; j < NT; j += 3) {
      PP_MMA3(1, 0); SBAR(); PP_ISSUE(j); PP_SOFTMAX(); PP_WAITL(j); PP_BAR();
      PP_MMA3(2, 1); SBAR(); PP_ISSUE(j + 1); PP_SOFTMAX(); PP_WAITL(j + 1); PP_BAR();
      PP_MMA3(0, 2); SBAR(); PP_ISSUE(j + 2); PP_SOFTMAX(); PP_WAITL(j + 2); PP_BAR(); }
  } else {
    PP_ISSUE(0); pp_mma<false>(S0, S1, o, qr, pa0, pa1, pa2, pa3, kb[0], kb[1], kb[2], kb[3], vb0); PP_WAITL(0); PP_BAR();
#pragma unroll 1
    for (int j = 1; j < NT; j += 3) {
      PP_ISSUE(j); PP_SOFTMAX(); SBAR(); PP_MMA3(1, 0); PP_WAITL(j); PP_BAR();
      PP_ISSUE(j + 1); PP_SOFTMAX(); SBAR(); PP_MMA3(2, 1); PP_WAITL(j + 1); PP_BAR();
      PP_ISSUE(j + 2); PP_SOFTMAX(); SBAR(); PP_MMA3(0, 2); PP_WAITL(j + 2); PP_BAR(); }
    PP_SOFTMAX(); SBAR();
  }
  pp_pv_tail(o, pa0, pa1, pa2, pa3, vb0 + PP_SLOT(NT - 1));
  if (PP_PRIO && role) __builtin_amdgcn_s_setprio(0);
  const int er = lane >> 4, ec = (lane & 15) * 8;
  const bf16* Gw = Gb + (size_t)(wid * 32 + er) * 128 + ec; bf16* Ow = Ob + (size_t)(wid * 32 + er) * KP + ec;
  bf16x8 gt[8];
#pragma unroll
  for (int i = 0; i < 8; ++i) gt[i] = ld8(Gw + (size_t)(i * 4) * 128);
  if (hi == 0) li_l[r32] = l_reg; asm volatile("s_waitcnt lgkmcnt(0)" ::: "memory");
  float rli[16];
#pragma unroll
  for (int r = 0; r < 16; ++r) rli[r] = __builtin_amdgcn_rcpf(li_l[crow(r, hi)]);
  __syncthreads();
  { unsigned short* stg = (unsigned short*)(lds + wid * 8192);
#pragma unroll
    for (int r = 0; r < 16; ++r) { const int orow = crow(r, hi);
#pragma unroll
      for (int d0 = 0; d0 < 4; ++d0) stg[orow * 128 + d0 * 32 + r32] = f2bf1(o[d0][r] * rli[r]); }
    asm volatile("s_waitcnt lgkmcnt(0)" ::: "memory");
#pragma unroll
    for (int i = 0; i < 8; ++i) { float ov[8], gv[8]; unpack8(*(const bf16x8*)(stg + (i * 4 + er) * 128 + ec), ov); unpack8(gt[i], gv);
#pragma unroll
      for (int e = 0; e < 8; ++e) ov[e] *= silu_f(gv[e]);
      *(bf16x8*)(Ow + (size_t)(i * 4) * KP) = pack8(ov); } }
  asm volatile("s_waitcnt vmcnt(0)" ::: "memory");
  __syncthreads();
#undef PP_SLOT
#undef PP_SOFTMAX
#undef PP_MMA3
#undef PP_DMA_K
#undef PP_DMA_V
#undef PP_ISSUE
#undef PP_WAITL
#undef PP_BAR
#undef RESC
}

__device__ __forceinline__ s16x4 tr_read16(int vb, int off) { s16x4 r; asm volatile("ds_read_b64_tr_b16 %0, %1" : "=&v"(r) : "v"(vb + off) : "memory"); return r; }
template <bool HASPV, int KS, int VS> __device__ __forceinline__ void p16_mma(f32x4 (&S)[4][2], f32x4 (&O)[2][8], const bf16x8 (&qr)[2][4], const bf16x8 (&pa)[2][2], const int* ka  , int vb) {
#define P16_W(n) do { asm volatile("s_waitcnt lgkmcnt(" #n ")" ::: "memory"); SBAR(); } while (0)
#define P16_KMM(ds, kb, f) do { S[kb][0] = __builtin_amdgcn_mfma_f32_16x16x32_bf16(f, qr[0][ds], S[kb][0], 0, 0, 0); S[kb][1] = __builtin_amdgcn_mfma_f32_16x16x32_bf16(f, qr[1][ds], S[kb][1], 0, 0, 0); } while (0)
#define P16_VMM(s, db, lo, hi) do { const bf16x8 vf_ = PKV(lo, hi); O[0][db] = __builtin_amdgcn_mfma_f32_16x16x32_bf16(pa[s][0], vf_, O[0][db], 0, 0, 0); O[1][db] = __builtin_amdgcn_mfma_f32_16x16x32_bf16(pa[s][1], vf_, O[1][db], 0, 0, 0); } while (0)
#pragma unroll
  for (int kb = 0; kb < 4; ++kb) { S[kb][0] = (f32x4){0.f, 0.f, 0.f, 0.f}; S[kb][1] = (f32x4){0.f, 0.f, 0.f, 0.f}; }
  if constexpr (HASPV) {
    const bf16x8 kfa0 = k_read<0 + KS>(ka[0]);
    const bf16x8 kfa1 = k_read<4096 + KS>(ka[0]);
    const bf16x8 kfa2 = k_read<8192 + KS>(ka[0]);
    const bf16x8 kfa3 = k_read<12288 + KS>(ka[0]);
    P16_W(3);
    P16_KMM(0, 0, kfa0);
    const bf16x8 kfa4 = k_read<0 + KS>(ka[1]);
    P16_W(3);
    P16_KMM(0, 1, kfa1);
    const bf16x8 kfa5 = k_read<4096 + KS>(ka[1]);
    P16_W(3);
    P16_KMM(0, 2, kfa2);
    const bf16x8 kfa6 = k_read<8192 + KS>(ka[1]);
    P16_W(3);
    P16_KMM(0, 3, kfa3);
    const bf16x8 kfa7 = k_read<12288 + KS>(ka[1]);
    P16_W(3);
    P16_KMM(1, 0, kfa4);
    const bf16x8 kfa8 = k_read<0 + KS>(ka[2]);
    P16_W(3);
    P16_KMM(1, 1, kfa5);
    const bf16x8 kfa9 = k_read<4096 + KS>(ka[2]);
    P16_W(3);
    P16_KMM(1, 2, kfa6);
    const bf16x8 kfa10 = k_read<8192 + KS>(ka[2]);
    P16_W(3);
    P16_KMM(1, 3, kfa7);
    const bf16x8 kfa11 = k_read<12288 + KS>(ka[2]);
    P16_W(3);
    P16_KMM(2, 0, kfa8);
    const bf16x8 kfa12 = k_read<0 + KS>(ka[3]);
    P16_W(3);
    P16_KMM(2, 1, kfa9);
    const bf16x8 kfa13 = k_read<4096 + KS>(ka[3]);
    P16_W(3);
    P16_KMM(2, 2, kfa10);
    const bf16x8 kfa14 = k_read<8192 + KS>(ka[3]);
    P16_W(3);
    P16_KMM(2, 3, kfa11);
    const bf16x8 kfa15 = k_read<12288 + KS>(ka[3]);
    P16_W(3);
    P16_KMM(3, 0, kfa12);
    const s16x4 vla16 = tr_read<0 + VS>(vb), vha16 = tr_read<4096 + VS>(vb);
    P16_W(4);
    P16_KMM(3, 1, kfa13);
    const s16x4 vla17 = tr_read<256 + VS>(vb), vha17 = tr_read<4352 + VS>(vb);
    P16_W(5);
    P16_KMM(3, 2, kfa14);
    const s16x4 vla18 = tr_read<512 + VS>(vb), vha18 = tr_read<4608 + VS>(vb);
    P16_W(6);
    P16_KMM(3, 3, kfa15);
    const s16x4 vla19 = tr_read<768 + VS>(vb), vha19 = tr_read<4864 + VS>(vb);
    P16_W(6);
    P16_VMM(0, 0, vla16, vha16);
    const s16x4 vla20 = tr_read<1024 + VS>(vb), vha20 = tr_read<5120 + VS>(vb);
    P16_W(6);
    P16_VMM(0, 1, vla17, vha17);
    const s16x4 vla21 = tr_read<1280 + VS>(vb), vha21 = tr_read<5376 + VS>(vb);
    P16_W(6);
    P16_VMM(0, 2, vla18, vha18);
    const s16x4 vla22 = tr_read<1536 + VS>(vb), vha22 = tr_read<5632 + VS>(vb);
    P16_W(6);
    P16_VMM(0, 3, vla19, vha19);
    const s16x4 vla23 = tr_read<1792 + VS>(vb), vha23 = tr_read<5888 + VS>(vb);
    P16_W(6);
    P16_VMM(0, 4, vla20, vha20);
    const s16x4 vla24 = tr_read<8192 + VS>(vb), vha24 = tr_read<12288 + VS>(vb);
    P16_W(6);
    P16_VMM(0, 5, vla21, vha21);
    const s16x4 vla25 = tr_read<8448 + VS>(vb), vha25 = tr_read<12544 + VS>(vb);
    P16_W(6);
    P16_VMM(0, 6, vla22, vha22);
    const s16x4 vla26 = tr_read<8704 + VS>(vb), vha26 = tr_read<12800 + VS>(vb);
    P16_W(6);
    P16_VMM(0, 7, vla23, vha23);
    const s16x4 vla27 = tr_read<8960 + VS>(vb), vha27 = tr_read<13056 + VS>(vb);
    P16_W(6);
    P16_VMM(1, 0, vla24, vha24);
    const s16x4 vla28 = tr_read<9216 + VS>(vb), vha28 = tr_read<13312 + VS>(vb);
    P16_W(6);
    P16_VMM(1, 1, vla25, vha25);
    const s16x4 vla29 = tr_read<9472 + VS>(vb), vha29 = tr_read<13568 + VS>(vb);
    P16_W(6);
    P16_VMM(1, 2, vla26, vha26);
    const s16x4 vla30 = tr_read<9728 + VS>(vb), vha30 = tr_read<13824 + VS>(vb);
    P16_W(6);
    P16_VMM(1, 3, vla27, vha27);
    const s16x4 vla31 = tr_read<9984 + VS>(vb), vha31 = tr_read<14080 + VS>(vb);
    P16_W(6);
    P16_VMM(1, 4, vla28, vha28);
    P16_W(4);
    P16_VMM(1, 5, vla29, vha29);
    P16_W(2);
    P16_VMM(1, 6, vla30, vha30);
    P16_W(0);
    P16_VMM(1, 7, vla31, vha31);
  } else {
    const bf16x8 kfb0 = k_read<0 + KS>(ka[0]);
    const bf16x8 kfb1 = k_read<4096 + KS>(ka[0]);
    const bf16x8 kfb2 = k_read<8192 + KS>(ka[0]);
    const bf16x8 kfb3 = k_read<12288 + KS>(ka[0]);
    P16_W(3);
    P16_KMM(0, 0, kfb0);
    const bf16x8 kfb4 = k_read<0 + KS>(ka[1]);
    P16_W(3);
    P16_KMM(0, 1, kfb1);
    const bf16x8 kfb5 = k_read<4096 + KS>(ka[1]);
    P16_W(3);
    P16_KMM(0, 2, kfb2);
    const bf16x8 kfb6 = k_read<8192 + KS>(ka[1]);
    P16_W(3);
    P16_KMM(0, 3, kfb3);
    const bf16x8 kfb7 = k_read<12288 + KS>(ka[1]);
    P16_W(3);
    P16_KMM(1, 0, kfb4);
    const bf16x8 kfb8 = k_read<0 + KS>(ka[2]);
    P16_W(3);
    P16_KMM(1, 1, kfb5);
    const bf16x8 kfb9 = k_read<4096 + KS>(ka[2]);
    P16_W(3);
    P16_KMM(1, 2, kfb6);
    const bf16x8 kfb10 = k_read<8192 + KS>(ka[2]);
    P16_W(3);
    P16_KMM(1, 3, kfb7);
    const bf16x8 kfb11 = k_read<12288 + KS>(ka[2]);
    P16_W(3);
    P16_KMM(2, 0, kfb8);
    const bf16x8 kfb12 = k_read<0 + KS>(ka[3]);
    P16_W(3);
    P16_KMM(2, 1, kfb9);
    const bf16x8 kfb13 = k_read<4096 + KS>(ka[3]);
    P16_W(3);
    P16_KMM(2, 2, kfb10);
    const bf16x8 kfb14 = k_read<8192 + KS>(ka[3]);
    P16_W(3);
    P16_KMM(2, 3, kfb11);
    const bf16x8 kfb15 = k_read<12288 + KS>(ka[3]);
    P16_W(3);
    P16_KMM(3, 0, kfb12);
    P16_W(2);
    P16_KMM(3, 1, kfb13);
    P16_W(1);
    P16_KMM(3, 2, kfb14);
    P16_W(0);
    P16_KMM(3, 3, kfb15);
  }
#undef P16_W
#undef P16_KMM
#undef P16_VMM
}
__device__ __forceinline__ void p16_pv_tail(f32x4 (&O)[2][8], const bf16x8 (&pa)[2][2], int vb) {
#define P16_W(n) do { asm volatile("s_waitcnt lgkmcnt(" #n ")" ::: "memory"); SBAR(); } while (0)
#define P16_VMM(s, db, lo, hi) do { const bf16x8 vf_ = PKV(lo, hi); O[0][db] = __builtin_amdgcn_mfma_f32_16x16x32_bf16(pa[s][0], vf_, O[0][db], 0, 0, 0); O[1][db] = __builtin_amdgcn_mfma_f32_16x16x32_bf16(pa[s][1], vf_, O[1][db], 0, 0, 0); } while (0)
  const s16x4 vlt0 = tr_read<0>(vb), vht0 = tr_read<4096>(vb);
  const s16x4 vlt1 = tr_read<256>(vb), vht1 = tr_read<4352>(vb);
  const s16x4 vlt2 = tr_read<512>(vb), vht2 = tr_read<4608>(vb);
  const s16x4 vlt3 = tr_read<768>(vb), vht3 = tr_read<4864>(vb);
  P16_W(6);
  P16_VMM(0, 0, vlt0, vht0);
  const s16x4 vlt4 = tr_read<1024>(vb), vht4 = tr_read<5120>(vb);
  P16_W(6);
  P16_VMM(0, 1, vlt1, vht1);
  const s16x4 vlt5 = tr_read<1280>(vb), vht5 = tr_read<5376>(vb);
  P16_W(6);
  P16_VMM(0, 2, vlt2, vht2);
  const s16x4 vlt6 = tr_read<1536>(vb), vht6 = tr_read<5632>(vb);
  P16_W(6);
  P16_VMM(0, 3, vlt3, vht3);
  const s16x4 vlt7 = tr_read<1792>(vb), vht7 = tr_read<5888>(vb);
  P16_W(6);
  P16_VMM(0, 4, vlt4, vht4);
  const s16x4 vlt8 = tr_read<8192>(vb), vht8 = tr_read<12288>(vb);
  P16_W(6);
  P16_VMM(0, 5, vlt5, vht5);
  const s16x4 vlt9 = tr_read<8448>(vb), vht9 = tr_read<12544>(vb);
  P16_W(6);
  P16_VMM(0, 6, vlt6, vht6);
  const s16x4 vlt10 = tr_read<8704>(vb), vht10 = tr_read<12800>(vb);
  P16_W(6);
  P16_VMM(0, 7, vlt7, vht7);
  const s16x4 vlt11 = tr_read<8960>(vb), vht11 = tr_read<13056>(vb);
  P16_W(6);
  P16_VMM(1, 0, vlt8, vht8);
  const s16x4 vlt12 = tr_read<9216>(vb), vht12 = tr_read<13312>(vb);
  P16_W(6);
  P16_VMM(1, 1, vlt9, vht9);
  const s16x4 vlt13 = tr_read<9472>(vb), vht13 = tr_read<13568>(vb);
  P16_W(6);
  P16_VMM(1, 2, vlt10, vht10);
  const s16x4 vlt14 = tr_read<9728>(vb), vht14 = tr_read<13824>(vb);
  P16_W(6);
  P16_VMM(1, 3, vlt11, vht11);
  const s16x4 vlt15 = tr_read<9984>(vb), vht15 = tr_read<14080>(vb);
  P16_W(6);
  P16_VMM(1, 4, vlt12, vht12);
  P16_W(4);
  P16_VMM(1, 5, vlt13, vht13);
  P16_W(2);
  P16_VMM(1, 6, vlt14, vht14);
  P16_W(0);
  P16_VMM(1, 7, vlt15, vht15);
#undef P16_W
#undef P16_VMM
}
__device__ __forceinline__ void p16_softmax(f32x4 (&S)[4][2], float (&lsum)[2], bf16x8 (&pa)[2][2]) {
#pragma unroll
  for (int qb = 0; qb < 2; ++qb) { float ps = 0.f;
#pragma unroll
    for (int s = 0; s < 2; ++s) {
      float e[8];
#pragma unroll
      for (int i = 0; i < 8; ++i) { e[i] = __builtin_amdgcn_exp2f(S[2 * s + (i >> 2)][qb][i & 3]); ps += e[i]; }
      u32x4 w_ = {cvtpk(e[0], e[1]), cvtpk(e[2], e[3]), cvtpk(e[4], e[5]), cvtpk(e[6], e[7])};
      pa[s][qb] = *reinterpret_cast<bf16x8*>(&w_);
      asm volatile("" : "+v"(ps));
      SBAR(); }
    lsum[qb] += ps; asm volatile("" : "+v"(lsum[qb])); }
}
__device__ __forceinline__ void attn_unit_p16(const bf16* __restrict__ Qb, const bf16* __restrict__ Kh, const bf16* __restrict__ Vh, const bf16* __restrict__ Gb, const float* __restrict__ ssq, bf16* __restrict__ Ob, char* lds, LAS unsigned char* ldsl) {
  int tid = threadIdx.x; asm volatile("" : "+v"(tid));
  const int wid = __builtin_amdgcn_readfirstlane(tid >> 6), lane = tid & 63, c16 = lane & 15, g = lane >> 4, role = wid >> 2;
  char* V_lds = lds; char* K_lds = lds + 3 * SHM_V;
  LAS float* li_l = (LAS float*)(ldsl + 3 * SHM_V + 3 * SHM_K) + wid * 64;
  unsigned koff[2], voff[2];
#pragma unroll
  for (int i = 0; i < 2; ++i) { const int blk = 2 * wid + i;
    { const int row = 4 * blk + (lane >> 4), chunk = (lane & 15) ^ (row & 15); koff[i] = (unsigned)(row * 128 + chunk * 8) * 2u; }
    { const int p = blk * 64 + lane, id = p >> 4, rho = (p & 15) >> 1, hh = p & 1, key = 8 * (id >> 3) + rho, d = 16 * (id & 7) + 8 * hh; voff[i] = (unsigned)(key * 128 + d) * 2u; } }
#define PP_SLOT(t) (((t) - 3 * (((t) * 43) >> 7)) * SHM_V)
  const unsigned ldsb_ = (unsigned)(size_t)ldsl;
  const __amdgpu_buffer_rsrc_t srdK_ = __builtin_amdgcn_make_buffer_rsrc((void*)Kh, (short)0, SEQ * 128 * 2, 0x00020000), srdV_ = __builtin_amdgcn_make_buffer_rsrc((void*)Vh, (short)0, SEQ * 128 * 2, 0x00020000);
#define PP_DMA_K(t) do { const unsigned so_ = (unsigned)PP_SLOT(t), tb_ = (unsigned)(t) * (64u * 128u * 2u); _Pragma("unroll") for (int i_ = 0; i_ < 2; ++i_) \
    asm volatile("s_nop 4\n\ts_mov_b32 m0, %0\n\ts_nop 0\n\tbuffer_load_dwordx4 %1, %2, %3 offen lds" :: "s"(ldsb_ + 3u * SHM_V + so_ + (unsigned)(2 * wid + i_) * 1024u), "v"(koff[i_]), "s"(srdK_), "s"(tb_) : "m0", "memory"); } while (0)
#define PP_DMA_V(t) do { const unsigned so_ = (unsigned)PP_SLOT(t), tb_ = (unsigned)(t) * (64u * 128u * 2u); _Pragma("unroll") for (int i_ = 0; i_ < 2; ++i_) \
    asm volatile("s_nop 4\n\ts_mov_b32 m0, %0\n\ts_nop 0\n\tbuffer_load_dwordx4 %1, %2, %3 offen lds" :: "s"(ldsb_ + so_ + (unsigned)(2 * wid + i_) * 1024u), "v"(voff[i_]), "s"(srdV_), "s"(tb_) : "m0", "memory"); } while (0)
#define PP_ISSUE(t) do { if ((t) + 2 < NT) PP_DMA_K((t) + 2); if ((t) + 1 < NT) PP_DMA_V((t) + 1); } while (0)
#define PP_WAITL(t) do { if ((t) + 2 < NT) asm volatile("s_waitcnt vmcnt(4)" ::: "memory"); else if ((t) + 1 < NT) asm volatile("s_waitcnt vmcnt(2)" ::: "memory"); else asm volatile("s_waitcnt vmcnt(0)" ::: "memory"); } while (0)
#define PP_BAR() do { SBAR(); asm volatile("" ::: "memory"); __builtin_amdgcn_s_barrier(); asm volatile("" ::: "memory"); SBAR(); } while (0)
  constexpr int NT = SEQ / 64; static_assert((NT - 1) % 3 == 0, "tile loop unrolled by the ring period");
  PP_DMA_K(0); PP_DMA_K(1); PP_DMA_V(0);
  f32x4 O[2][8]; bf16x8 qr[2][4]; float lsum[2] = {0.f, 0.f};
#pragma unroll
  for (int qb = 0; qb < 2; ++qb)
#pragma unroll
    for (int db = 0; db < 8; ++db) O[qb][db] = (f32x4){0.f, 0.f, 0.f, 0.f};
#pragma unroll
  for (int qb = 0; qb < 2; ++qb) { const bf16* Qw = Qb + (size_t)(wid * 32 + 16 * qb + c16) * 128 + 8 * g;
#pragma unroll
    for (int ds = 0; ds < 4; ++ds) qr[qb][ds] = ld8(Qw + 32 * ds); }
  float Cq[2];
#pragma unroll
  for (int qb = 0; qb < 2; ++qb) { const f32x4 pq = *(const f32x4*)(ssq + (size_t)(wid * 32 + 16 * qb + c16) * 64); Cq[qb] = ATT_SCALE * 1.4426950408889634f / sqrtf(((pq.x + pq.y) + (pq.z + pq.w)) * (1.f / 128.f) + EPS); }
  int ka[4];
#pragma unroll
  for (int ds = 0; ds < 4; ++ds) ka[ds] = (int)(uintptr_t)K_lds + c16 * 256 + (((4 * ds + g) ^ c16) << 4);
  const int vb0 = (int)(uintptr_t)V_lds + ((g >> 1) * 8) * 256 + (4 * (g & 1) + ((lane & 15) >> 2)) * 32 + (lane & 3) * 8;
  f32x4 S[4][2]; bf16x8 pa[2][2];
  asm volatile("s_waitcnt vmcnt(0) lgkmcnt(0)" ::: "memory");
#pragma unroll
  for (int qb = 0; qb < 2; ++qb)
#pragma unroll
    for (int ds = 0; ds < 4; ++ds) { qr[qb][ds] = scale8(qr[qb][ds], Cq[qb]); asm volatile("" : "+v"(qr[qb][ds])); }
  PP_BAR();
#define P16_MMA3(KSL, VSL) p16_mma<true, (KSL) * SHM_K, (VSL) * SHM_V>(S, O, qr, pa, ka, vb0)
  if (role == 0) {
    p16_mma<false, 0, 0>(S, O, qr, pa, ka, vb0); SBAR(); PP_ISSUE(0); p16_softmax(S, lsum, pa); PP_WAITL(0); PP_BAR();
#pragma unroll 1
    for (int j = 1; j < NT; j += 3) {
      P16_MMA3(1, 0); SBAR(); PP_ISSUE(j); p16_softmax(S, lsum, pa); PP_WAITL(j); PP_BAR();
      P16_MMA3(2, 1); SBAR(); PP_ISSUE(j + 1); p16_softmax(S, lsum, pa); PP_WAITL(j + 1); PP_BAR();
      P16_MMA3(0, 2); SBAR(); PP_ISSUE(j + 2); p16_softmax(S, lsum, pa); PP_WAITL(j + 2); PP_BAR(); }
  } else {
    PP_ISSUE(0); p16_mma<false, 0, 0>(S, O, qr, pa, ka, vb0); PP_WAITL(0); PP_BAR();
#pragma unroll 1
    for (int j = 1; j < NT; j += 3) {
      PP_ISSUE(j); p16_softmax(S, lsum, pa); SBAR(); P16_MMA3(1, 0); PP_WAITL(j); PP_BAR();
      PP_ISSUE(j + 1); p16_softmax(S, lsum, pa); SBAR(); P16_MMA3(2, 1); PP_WAITL(j + 1); PP_BAR();
      PP_ISSUE(j + 2); p16_softmax(S, lsum, pa); SBAR(); P16_MMA3(0, 2); PP_WAITL(j + 2); PP_BAR(); }
    p16_softmax(S, lsum, pa); SBAR();
  }
  p16_pv_tail(O, pa, vb0 + PP_SLOT(NT - 1));
  int te_ = threadIdx.x; asm volatile("" : "+v"(te_));
  const int le = te_ & 63, ce = le & 15, ge = le >> 4;
  LAS float* li_e = (LAS float*)(ldsl + 3 * SHM_V + 3 * SHM_K) + wid * 64;
  float rli[2][4];
#pragma unroll
  for (int qb = 0; qb < 2; ++qb) { const float lt = pg8::row4_sum(lsum[qb]); if (ge == 0) li_e[16 * qb + ce] = lt; }
  asm volatile("s_waitcnt lgkmcnt(0)" ::: "memory");
#pragma unroll
  for (int qb = 0; qb < 2; ++qb)
#pragma unroll
    for (int r = 0; r < 4; ++r) rli[qb][r] = __builtin_amdgcn_rcpf(li_e[16 * qb + 4 * ge + r]);
  __syncthreads();
  { LAS unsigned short* stg = (LAS unsigned short*)(ldsl + wid * 8192);
#pragma unroll
    for (int qb = 0; qb < 2; ++qb)
#pragma unroll
      for (int db = 0; db < 8; ++db)
#pragma unroll
        for (int r = 0; r < 4; ++r) stg[(16 * qb + 4 * ge + r) * 128 + 16 * db + ce] = f2bf1(O[qb][db][r] * rli[qb][r]);
    asm volatile("s_waitcnt lgkmcnt(0)" ::: "memory");
    const int er = le >> 4, ec = (le & 15) * 8;
    const bf16* Gw = Gb + (size_t)(wid * 32 + er) * 128 + ec; bf16* Ow = Ob + (size_t)(wid * 32 + er) * KP + ec;
#pragma unroll
    for (int i = 0; i < 8; ++i) { float ov[8], gv[8]; unpack8(*(const LAS bf16x8*)(stg + (i * 4 + er) * 128 + ec), ov); unpack8(ld8(Gw + (size_t)(i * 4) * 128), gv);
#pragma unroll
      for (int e = 0; e < 8; ++e) ov[e] *= silu_f(gv[e]);
      *(bf16x8*)(Ow + (size_t)(i * 4) * KP) = pack8(ov); asm volatile("" ::: "memory"); } }
  asm volatile("s_waitcnt vmcnt(0)" ::: "memory");
  __syncthreads();
#undef PP_SLOT
#undef PP_DMA_K
#undef PP_DMA_V
#undef PP_ISSUE
#undef PP_WAITL
#undef PP_BAR
#undef P16_MMA3
}

__device__ __forceinline__ s16x4 tr_read_rt(int addr) { s16x4 r; asm volatile("ds_read_b64_tr_b16 %0, %1" : "=&v"(r) : "v"(addr) : "memory"); return r; }
__device__ __forceinline__ void scan_unit(int b, int h, int dir, int es, const bf16* __restrict__ RV, const bf16* __restrict__ RKC, bf16* __restrict__ FST, float lg2, char* lds) {
  int tid = threadIdx.x; asm volatile("" : "+v"(tid));
  const int wid = tid >> 6, lane = tid & 63, r32 = lane & 31, hi = lane >> 5, db = wid & 3, eb = wid >> 2;
  char* Kl = lds; char* Vl = lds + 32768;
  const int vbK = (int)(uintptr_t)Kl + v_rd_base(lane) + db * 512, vbV = (int)(uintptr_t)Vl + v_rd_base(lane) + eb * 512;
  const float gC = __builtin_amdgcn_exp2f(lg2 * 128.f);
  const int sr = tid >> 4, sc = (tid & 15) * 8;
  const bf16* Kg = RKC + (size_t)(b * RH + h) * SEQ * 128;
  const bf16* Vg = RV + (size_t)(b * RH + h) * SEQ * 256 + es * 64;
  bf16* Fbase = FST + ((((size_t)dir * BATCH + b) * RH + h) * NCH) * 32768 + es * 64 + eb * 32 + r32;
  f32x16 acc = {};
  bf16x8 kA[4], vA[2], kB[4], vB[2], kC[4], vC[2];
#define SC_LOAD(KR, VR, j) do { const size_t rb_ = (size_t)(j) * 128; \
    _Pragma("unroll") for (int q_ = 0; q_ < 4; ++q_) KR[q_] = ld8(Kg + (rb_ + (q_ >> 1) * 64 + sr + 32 * (q_ & 1)) * 128 + sc); \
    _Pragma("unroll") for (int i_ = 0; i_ < 2; ++i_) { const int p_ = tid + 512 * i_; VR[i_] = ld8(Vg + (rb_ + (p_ >> 3)) * 256 + (p_ & 7) * 8); } } while (0)
#define SC_WRITE(KR, VR) do { \
    _Pragma("unroll") for (int q_ = 0; q_ < 4; ++q_) { const int row_ = sr + 32 * (q_ & 1), m_ = (q_ >> 1) * 64 + row_; \
        const float z_ = __builtin_amdgcn_exp2f(lg2 * (float)(dir ? m_ : 127 - m_)); *(bf16x8*)(Kl + (q_ >> 1) * 16384 + v_st(row_, sc)) = scale8(KR[q_], z_); } \
    _Pragma("unroll") for (int i_ = 0; i_ < 2; ++i_) { const int p_ = tid + 512 * i_, m_ = p_ >> 3; *(bf16x8*)(Vl + (m_ >> 6) * 16384 + v_st(m_ & 63, (p_ & 7) * 8)) = VR[i_]; } } while (0)
#define SC_CHUNK(s) (dir ? NCH - 1 - (s) : (s))
  unsigned short* Stg = (unsigned short*)(lds + 65536); bf16* Fslice = FST + ((((size_t)dir * BATCH + b) * RH + h) * NCH) * 32768 + es * 64;
#define SC_STAGE() do { _Pragma("unroll") for (int r = 0; r < 16; ++r) Stg[(db * 32 + crow(r, hi)) * 64 + eb * 32 + r32] = f2bf1(acc[r]); } while (0)
#define SC_FLUSH(j) do { _Pragma("unroll") for (int i_ = 0; i_ < 2; ++i_) { const int q_ = tid + 512 * i_, d_ = q_ >> 3, ec_ = (q_ & 7) * 8; \
    *(bf16x8*)(Fslice + (size_t)(j) * 32768 + d_ * 256 + ec_) = *(const bf16x8*)(Stg + d_ * 64 + ec_); } } while (0)
#define SC_STEP(KR, VR, s) do { \
    SC_STAGE(); __syncthreads(); SC_WRITE(KR, VR); SC_FLUSH(SC_CHUNK(s)); __syncthreads(); \
    if ((s) + 3 < NCH - 1) SC_LOAD(KR, VR, SC_CHUNK((s) + 3)); \
    _Pragma("unroll") for (int r = 0; r < 16; ++r) acc[r] *= gC; \
    _Pragma("unroll") for (int kt = 0; kt < 2; ++kt) _Pragma("unroll") for (int ks = 0; ks < 4; ++ks) { \
        const s16x4 al = tr_read_rt(vbK + kt * 16384 + v_rd_off(0, ks, 0)), ah = tr_read_rt(vbK + kt * 16384 + v_rd_off(0, ks, 1)); \
        const s16x4 bl = tr_read_rt(vbV + kt * 16384 + v_rd_off(0, ks, 0)), bh = tr_read_rt(vbV + kt * 16384 + v_rd_off(0, ks, 1)); \
        asm volatile("s_waitcnt lgkmcnt(0)" ::: "memory"); SBAR(); \
        acc = __builtin_amdgcn_mfma_f32_32x32x16_bf16(PKV(al, ah), PKV(bl, bh), acc, 0, 0, 0); } } while (0)
  SC_LOAD(kA, vA, SC_CHUNK(0)); SC_LOAD(kB, vB, SC_CHUNK(1)); SC_LOAD(kC, vC, SC_CHUNK(2));
  for (int s0 = 0; s0 < NCH - 2; s0 += 3) {
    SC_STEP(kA, vA, s0); SC_STEP(kB, vB, s0 + 1); SC_STEP(kC, vC, s0 + 2);
  }
  SC_STEP(kA, vA, NCH - 2);
  SC_STAGE(); __syncthreads(); SC_FLUSH(SC_CHUNK(NCH - 1));
  __syncthreads();
#undef SC_STAGE
#undef SC_FLUSH
#undef SC_STEP
#undef SC_CHUNK
#undef SC_LOAD
#undef SC_WRITE
}

__device__ __forceinline__ void ret_out_unit(int b, int h, int j, const bf16* __restrict__ RV, const bf16* __restrict__ GR, const bf16* __restrict__ RQC, const bf16* __restrict__ RKC, const bf16* __restrict__ FST, bf16* __restrict__ MIX, const float* __restrict__ gn, float lgf2, float lgb2, char* lds) {
  int tid = threadIdx.x; asm volatile("" : "+v"(tid));
  const int wid = tid >> 6, lane = tid & 63, r32 = lane & 31, hi = lane >> 5, qw = wid & 3, ch = wid >> 2;
  char* Kl = lds; char* Vb = lds + 32768; float* ssx = (float*)(lds + 98304);
  const size_t row0 = (size_t)b * SEQ + (size_t)j * 128;
  const int nq = qw * 32 + r32;
  const size_t hrow0 = ((size_t)(b * RH + h) * SEQ + (size_t)j * 128) * 128;
  const bf16* Qw = RQC + hrow0 + (size_t)nq * 128 + hi * 8;
  bf16x8 qr[8];
#pragma unroll
  for (int d0 = 0; d0 < 8; ++d0) qr[d0] = ld8(Qw + d0 * 16);
  const int sr = tid >> 4, sc = (tid & 15) * 8;
  const bf16* Kg = RKC + hrow0;
  const bf16* Vg = RV + ((size_t)(b * RH + h) * SEQ + (size_t)j * 128) * 256;
  const bf16* Fg = FST + ((((size_t)0 * BATCH + b) * RH + h) * NCH + j) * 32768;
  const bf16* Gg = FST + ((((size_t)1 * BATCH + b) * RH + h) * NCH + j) * 32768;
  const int vb0 = (int)(uintptr_t)Vb + v_rd_base(lane) + ch * 16384;
  bf16x8 vsA[4], vsB[4];
#define VT_LOAD(VS, t) do { const bf16* s_ = (t) < 2 ? Vg + (size_t)((t) * 64) * 256 : ((t) < 4 ? Fg + ((t) - 2) * 64 * 256 : Gg + ((t) - 4) * 64 * 256); const size_t ld_ = (size_t)256; \
    _Pragma("unroll") for (int q_ = 0; q_ < 4; ++q_) VS[q_] = ld8(s_ + (size_t)(sr + 32 * (q_ & 1)) * ld_ + (q_ >> 1) * 128 + sc); } while (0)
#define VT_WRITE(VS, bf) do { _Pragma("unroll") for (int q_ = 0; q_ < 4; ++q_) *(bf16x8*)(Vb + (bf) * 32768 + (q_ >> 1) * 16384 + v_st(sr + 32 * (q_ & 1), sc)) = VS[q_]; } while (0)
  { bf16x8 kst[4];
#pragma unroll
    for (int q_ = 0; q_ < 4; ++q_) kst[q_] = ld8(Kg + (size_t)((q_ >> 1) * 64 + sr + 32 * (q_ & 1)) * 128 + sc);
    VT_LOAD(vsB, 0);
#pragma unroll
    for (int q_ = 0; q_ < 4; ++q_) *(bf16x8*)(Kl + (q_ >> 1) * 16384 + KSWZ(sr + 32 * (q_ & 1), sc * 2)) = kst[q_];
    VT_WRITE(vsB, 0); }
  VT_LOAD(vsA, 1); VT_LOAD(vsB, 2);
  __syncthreads();
  f32x16 o[4] = {};
  bf16x8 pa0, pa1, pa2, pa3;
  float fnq = (float)(nq - 4 * hi); asm volatile("" : "+v"(fnq));
  const float nlgb2 = -lgb2;
#define VT_ADVANCE(t) do { if ((t) < 5) { if (((t) & 1) == 0) { VT_WRITE(vsA, ((t) + 1) & 1); } else { VT_WRITE(vsB, ((t) + 1) & 1); } __syncthreads(); \
    if ((t) + 3 < 6) { if (((t) & 1) == 0) { VT_LOAD(vsA, (t) + 3); } else { VT_LOAD(vsB, (t) + 3); } } } } while (0)
#pragma unroll
  for (int t = 0; t < 2; ++t) {
    f32x16 p0, p1;
    qkt(p0, p1, Kl + t * 16384, qr, r32, hi);
#pragma unroll
    for (int r = 0; r < 16; ++r) {
      const float df0 = fnq - (float)(t * 64 + (r & 3) + 8 * (r >> 2)), df1 = df0 - 32.f;
      p0[r] *= __builtin_amdgcn_exp2f(fminf(lgf2 * df0, nlgb2 * df0));
      p1[r] *= __builtin_amdgcn_exp2f(fminf(lgf2 * df1, nlgb2 * df1));
    }
    PK4(p0, 0, pa0); PK4(p0, 8, pa1); PK4(p1, 0, pa2); PK4(p1, 8, pa3);
    SBAR();
    pv_d0(o, vb0 + (t & 1) * 32768, pa0, pa1, pa2, pa3);
    VT_ADVANCE(t);
  }
  const float xif = __builtin_amdgcn_exp2f(lgf2 * (float)(nq + 1)), xib = __builtin_amdgcn_exp2f(lgb2 * (float)(128 - nq));
#pragma unroll
  for (int t = 2; t < 6; ++t) {
    const float xs = t < 4 ? xif : xib; const int dt = t & 1;
    pa0 = scale8(qr[4 * dt + 0], xs); pa1 = scale8(qr[4 * dt + 1], xs); pa2 = scale8(qr[4 * dt + 2], xs); pa3 = scale8(qr[4 * dt + 3], xs);
    SBAR();
    pv_d0(o, vb0 + (t & 1) * 32768, pa0, pa1, pa2, pa3);
    VT_ADVANCE(t);
  }
#undef VT_ADVANCE
  float ssq[16];
#pragma unroll
  for (int r = 0; r < 16; ++r) { float s = o[0][r] * o[0][r] + o[1][r] * o[1][r] + o[2][r] * o[2][r] + o[3][r] * o[3][r];
    ssq[r] = xsum32(s); }
  if (r32 == 0) {
#pragma unroll
    for (int r = 0; r < 16; ++r) ssx[(qw * 32 + crow(r, hi)) * 2 + ch] = ssq[r];
  }
  __syncthreads();
  { unsigned short* stg = (unsigned short*)(lds + wid * 8192);
    float gcol[4];
#pragma unroll
    for (int d0 = 0; d0 < 4; ++d0) gcol[d0] = gn[ch * 128 + d0 * 32 + r32];
#pragma unroll
    for (int r = 0; r < 16; ++r) { const int row = qw * 32 + crow(r, hi); const float rstd = 1.0f / sqrtf((ssx[row * 2] + ssx[row * 2 + 1]) * (1.f / 256.f) + EPS);
#pragma unroll
      for (int d0 = 0; d0 < 4; ++d0) stg[crow(r, hi) * 128 + d0 * 32 + r32] = f2bf1(o[d0][r] * rstd * gcol[d0]); }
    asm volatile("s_waitcnt lgkmcnt(0)" ::: "memory");
    const int er = lane >> 4, ec = (lane & 15) * 8;
    const bf16* Gw = GR + ((size_t)(b * RH + h) * SEQ + (size_t)j * 128 + qw * 32 + er) * 256 + ch * 128 + ec; bf16* Ow = MIX + (row0 + qw * 32 + er) * KP + 2048 + h * 256 + ch * 128 + ec;
#pragma unroll
    for (int i = 0; i < 8; ++i) { float ov[8], gv[8]; unpack8(*(const bf16x8*)(stg + (i * 4 + er) * 128 + ec), ov); unpack8(ld8(Gw + (size_t)(i * 4) * 256), gv);
#pragma unroll
      for (int e = 0; e < 8; ++e) ov[e] *= silu_f(gv[e]);
      *(bf16x8*)(Ow + (size_t)(i * 4) * KP) = pack8(ov); asm volatile("" ::: "memory"); } }
  __syncthreads();
#undef VT_LOAD
#undef VT_WRITE
}

struct Frame {
    LAS unsigned char* lds;
    volatile LAS unsigned* MISC;
    gu32* ctl;
    int tid, lane, wave;
    int vcu, G;
};

__device__ __forceinline__ int rope_perm_row(int n) {
    const bool roped = n < C_AV || (n >= C_RQ && n < C_RV);
    if (!roped) return n;
    const int d = n & 127, hb = d >> 6, nn = (d >> 5) & 1, w1 = (d >> 4) & 1, fq = (d >> 2) & 3, i = d & 3;
    return (n & ~127) + 32 * (2 * hb + w1) + 8 * fq + 4 * nn + i;
}
__device__ __forceinline__ void p0_transpose_item(const float* W, int K, int N, bf16* WT, int ldt, bool permrows, const float* rowscale, LAS float* scr, int item, int lane) {
    const int nblk = N / 32, kb = item / nblk, nb = item % nblk, k0 = 64 * kb, n0 = 32 * nb;
    if (rowscale) {
#pragma unroll 8
        for (int i = 0; i < 32; ++i) { const int kk = 2 * i + (lane >> 5); scr[kk * 33 + (lane & 31)] = W[(size_t)(k0 + kk) * N + n0 + (lane & 31)] * rowscale[k0 + kk]; }
    } else {
#pragma unroll 8
        for (int i = 0; i < 32; ++i) { const int kk = 2 * i + (lane >> 5); scr[kk * 33 + (lane & 31)] = W[(size_t)(k0 + kk) * N + n0 + (lane & 31)]; }
    }
    LDS_WAIT(); asm volatile("" ::: "memory");
    const int c = lane & 7;
#pragma unroll
    for (int j = 0; j < 4; ++j) { const int n = (lane >> 3) + 8 * j; const LAS float* s = scr + (8 * c) * 33 + n;
        v4u o; o.x = pk2(s[0 * 33], s[1 * 33]); o.y = pk2(s[2 * 33], s[3 * 33]); o.z = pk2(s[4 * 33], s[5 * 33]); o.w = pk2(s[6 * 33], s[7 * 33]);
        *(GAS v4u*)(WT + (size_t)(permrows ? rope_perm_row(n0 + n) : n0 + n) * ldt + k0 + 8 * c) = o; }
    LDS_WAIT(); asm volatile("" ::: "memory");
}
__device__ __forceinline__ void rms_row_to_bf16(const float* xrow, const float* g, bf16* orow, int lane) {
    const GAS f32x4* xr = (const GAS f32x4*)xrow + lane;
    f32x4 v[16]; float s = 0.f;
#pragma unroll
    for (int j = 0; j < 16; ++j) { v[j] = xr[64 * j]; s += (v[j].x * v[j].x + v[j].y * v[j].y) + (v[j].z * v[j].z + v[j].w * v[j].w); }
    const float rstd = 1.f / sqrtf(wave_sum(s) * (1.f / DM) + EPS);
    GAS unsigned long long* o8 = (GAS unsigned long long*)orow + lane;
    const GAS f32x4* gr = (const GAS f32x4*)g + lane;
#pragma unroll
    for (int j = 0; j < 16; ++j) { const f32x4 gg = gr[64 * j]; o8[64 * j] = (unsigned long long)cvtpk(v[j].x * rstd * gg.x, v[j].y * rstd * gg.y) | ((unsigned long long)cvtpk(v[j].z * rstd * gg.z, v[j].w * rstd * gg.w) << 32); }
}
__device__ __forceinline__ void row_f32_to_bf16_rstd(const float* xrow, bf16* brow, float* rstd_out, int lane) {
    const GAS f32x4* xr = (const GAS f32x4*)xrow + lane;
    f32x4 v[16]; float s = 0.f;
#pragma unroll
    for (int j = 0; j < 16; ++j) { v[j] = xr[64 * j]; s += (v[j].x * v[j].x + v[j].y * v[j].y) + (v[j].z * v[j].z + v[j].w * v[j].w); }
    GAS unsigned long long* b8 = (GAS unsigned long long*)brow + lane;
#pragma unroll
    for (int j = 0; j < 16; ++j) b8[64 * j] = (unsigned long long)cvtpk(v[j].x, v[j].y) | ((unsigned long long)cvtpk(v[j].z, v[j].w) << 32);
    const float rstd = 1.f / sqrtf(wave_sum(s) * (1.f / DM) + EPS);
    if (lane == 0) *rstd_out = rstd;
}
__device__ __forceinline__ void row_bf16_rstd(const bf16* xrow, float* rstd_out, int lane) {
    bf16x8 v[8]; float s = 0.f;
#pragma unroll
    for (int j = 0; j < 8; ++j) v[j] = ld8(xrow + (size_t)(64 * j + lane) * 8);
#pragma unroll
    for (int j = 0; j < 8; ++j) { float f[8]; unpack8(v[j], f);
#pragma unroll
        for (int i = 0; i < 8; ++i) s += f[i] * f[i]; }
    const float rstd = 1.f / sqrtf(wave_sum(s) * (1.f / DM) + EPS);
    if (lane == 0) *rstd_out = rstd;
}
__device__ __forceinline__ void rms_row_bf16_to_f32(const bf16* xrow, const float* g, float* orow, int lane, bool poison) {
    bf16x8 v[8]; float s = 0.f;
#pragma unroll
    for (int j = 0; j < 8; ++j) { v[j] = ld8(xrow + (size_t)(64 * j + lane) * 8); float f[8]; unpack8(v[j], f);
#pragma unroll
        for (int i = 0; i < 8; ++i) s += f[i] * f[i]; }
    float rstd = 1.f / sqrtf(wave_sum(s) * (1.f / DM) + EPS); if (poison) rstd = __builtin_nanf("");
#pragma unroll
    for (int j = 0; j < 8; ++j) { float f[8]; unpack8(v[j], f); const GAS f32x4* gr = (const GAS f32x4*)(g + (size_t)(64 * j + lane) * 8); const f32x4 g0 = gr[0], g1 = gr[1];
        GAS f32x4* o4 = (GAS f32x4*)(orow + (size_t)(64 * j + lane) * 8);
        o4[0] = (f32x4){f[0] * rstd * g0.x, f[1] * rstd * g0.y, f[2] * rstd * g0.z, f[3] * rstd * g0.w}; o4[1] = (f32x4){f[4] * rstd * g1.x, f[5] * rstd * g1.y, f[6] * rstd * g1.z, f[7] * rstd * g1.w}; }
}
__device__ __forceinline__ void rms_row_to_f32(const float* xrow, const float* g, float* orow, int lane, bool poison) {
    const GAS f32x4* xr = (const GAS f32x4*)xrow + lane;
    f32x4 v[16]; float s = 0.f;
#pragma unroll
    for (int j = 0; j < 16; ++j) { v[j] = xr[64 * j]; s += (v[j].x * v[j].x + v[j].y * v[j].y) + (v[j].z * v[j].z + v[j].w * v[j].w); }
    float rstd = 1.f / sqrtf(wave_sum(s) * (1.f / DM) + EPS);
    if (poison) rstd = __builtin_nanf("");
    GAS f32x4* o4 = (GAS f32x4*)orow + lane;
    const GAS f32x4* gr = (const GAS f32x4*)g + lane;
#pragma unroll
    for (int j = 0; j < 16; ++j) { const f32x4 gg = gr[64 * j]; o4[64 * j] = v[j] * rstd * gg; }
}

struct Args { const float* in[10]; float* out; unsigned char* ws; int ph_lo, ph_hi; };

__global__ void __launch_bounds__(NWAVES * 64, 2) hymba_fwd(Args args) {
    extern __shared__ __attribute__((aligned(16))) unsigned char lds[];
    Frame F;
    F.lds = (LAS unsigned char*)lds;
    F.MISC = (volatile LAS unsigned*)(F.lds + MISC_OFF);
    F.tid = threadIdx.x; F.lane = F.tid & 63; F.wave = __builtin_amdgcn_readfirstlane(F.tid >> 6);
    F.G = gridDim.x; { const int bx = blockIdx.x; F.vcu = (F.G % 8 == 0) ? (bx % 8) * (F.G / 8) + bx / 8 : bx; }
    unsigned char* ws = args.ws;
    F.ctl = (gu32*)(ws + WS_CTL);
    const float* x_in = args.in[0]; const float* norm_w = args.in[1]; const float* w_in = args.in[2]; const float* q_norm = args.in[3]; const float* k_norm = args.in[4];
    const float* dec_f = args.in[5]; const float* dec_b = args.in[6]; const float* ret_norm = args.in[7]; const float* w_out = args.in[8]; const float* final_norm = args.in[9];
    float* ROPE = (float*)(ws + WS_ROPE); float* LG2T = ROPE + 4096;
    bf16* WIN = (bf16*)(ws + WS_WIN); bf16* WOUT = (bf16*)(ws + WS_WOUT); bf16* XCUR = (bf16*)(ws + WS_XCUR); float* RSTD = (float*)(ws + WS_XN); float* SSX = (float*)(ws + WS_XN + MiB);
    bf16* GA = (bf16*)(ws + WS_GA); bf16* RV = (bf16*)(ws + WS_RV); bf16* GR = (bf16*)(ws + WS_GR); float* SSQ = (float*)(ws + WS_SSQ); float* SSK = (float*)(ws + WS_SSK);
    bf16* MIX = (bf16*)(ws + WS_MIX); bf16* FST = (bf16*)(ws + WS_FST);
    bf16* QC = (bf16*)(ws + WS_QC); bf16* KC = (bf16*)(ws + WS_KC); bf16* VC = (bf16*)(ws + WS_VC); bf16* RQC = (bf16*)(ws + WS_RQC); bf16* RKC = (bf16*)(ws + WS_RKC);
    for (int u = F.tid; u < (LDS_BYTES - LDSCTL_OFF) / 4; u += NWAVES * 64) ((LAS unsigned*)(F.lds + LDSCTL_OFF))[u] = 0u;
    __syncthreads();
    XcdBarrier bar; bar.bar = (unsigned*)(F.ctl + CW_BAR); bar.x = 0; bar.st = nullptr;
    if (!MK_PER_PHASE) bar = xcd_barrier_post((unsigned*)(F.ctl + CW_BAR), F.MISC + 8);
#define GRID_BAR() do { if (!MK_PER_PHASE) xcd_barrier(bar); } while (0)
    const int lo = args.ph_lo, hi = args.ph_hi;
#define IN(k) (lo <= (k) && (k) < hi)
#define BOTH(k) (IN(k) && IN((k) + 1))
    const int gw = F.vcu * NWAVES + F.wave, NGW = F.G * NWAVES;

    if (PH_EN(0) && IN(0)) {
        LAS float* scr = (LAS float*)(F.lds + F.wave * 16384);
        constexpr int I_IN = (DM / 64) * (NIN / 32), I_OUT = (DM / 64) * (DM / 32), I_L = I_IN + I_OUT;
        for (int rep = 0; rep < DUP(0); ++rep)
        for (int it = gw; it < DEPTH * I_L; it += NGW) {
            const int l = it / I_L, r = it % I_L;
            if (r < I_IN) p0_transpose_item(w_in + (size_t)l * DM * NIN, DM, NIN, WIN + (size_t)l * NIN * KP, KP, true, norm_w + (size_t)l * DM, scr, r, F.lane);
            else p0_transpose_item(w_out + (size_t)l * DM * DM, DM, DM, WOUT + (size_t)l * DM * KP, KP, false, nullptr, scr, r - I_IN, F.lane);
        }
        const int gt = blockIdx.x * (NWAVES * 64) + F.tid;
        if (gt < 2048) {
            const int pos = gt >> 5, jf = gt & 31;
            double inv = 1.0; for (int i = 0; i < jf; ++i) inv *= 0.74989420933245582730;
            const float angf = (float)pos * (float)inv;
            const double a = (double)angf, kq = __builtin_rint(a * 0.63661977236758134308), rr = (a - kq * 1.5707963267948966192) - kq * 6.123233995736766e-17, r2 = rr * rr;
            const double sn = rr * (1.0 + r2 * (-1.0 / 6 + r2 * (1.0 / 120 + r2 * (-1.0 / 5040 + r2 * (1.0 / 362880 + r2 * (-1.0 / 39916800 + r2 * (1.0 / 6227020800.0)))))));
            const double cs = 1.0 + r2 * (-0.5 + r2 * (1.0 / 24 + r2 * (-1.0 / 720 + r2 * (1.0 / 40320 + r2 * (-1.0 / 3628800 + r2 * (1.0 / 479001600.0 + r2 * (-1.0 / 87178291200.0)))))));
            const int qd = ((int)kq) & 3;
            const double c = qd == 0 ? cs : qd == 1 ? -sn : qd == 2 ? -cs : sn, s = qd == 0 ? sn : qd == 1 ? cs : qd == 2 ? -sn : -cs;
            ROPE[gt] = (float)c; ROPE[2048 + gt] = (float)s;
        }
        if (gt < 2 * DEPTH * RH) LG2T[gt] = log2_sigmoid((gt < DEPTH * RH ? dec_f : dec_b)[gt % (DEPTH * RH)]);
    }

    for (int l = 0; l < DEPTH; ++l) {
        const int pb = 1 + 5 * l;
        if (PH_EN(1) && IN(pb)) {
            int tn_ = threadIdx.x; asm volatile("" : "+v"(tn_)); const int ln = tn_ & 63;
            int gwn = gw; asm volatile("" : "+s"(gwn));
            if (l == 0) { for (int m = gwn; m < M; m += NGW) row_f32_to_bf16_rstd(x_in + (size_t)m * DM, XCUR + (size_t)m * DM, RSTD + m, ln); }
            else { for (int m8 = gwn * 8; m8 < M; m8 += NGW * 8) {
                    const GAS f32x4* sp = (const GAS f32x4*)(SSX + (size_t)(m8 + (ln >> 3)) * 64 + 8 * (ln & 7)); const f32x4 a = sp[0], b = sp[1];
                    float t = ((a.x + a.y) + (a.z + a.w)) + ((b.x + b.y) + (b.z + b.w)); t = xsum8(t);
                    if ((ln & 7) == 0) RSTD[m8 + (ln >> 3)] = 1.f / sqrtf(t * (1.f / DM) + EPS); } }
            if (BOTH(pb)) GRID_BAR();
        }
        if (PH_EN(2) && IN(pb + 1)) {
            pg8::Gemm g{XCUR, WIN + (size_t)l * NIN * KP, M, NIN, DM, DM}; pg8::StaticOrder S; S.init(M, NIN, F.G, (int)blockIdx.x);
            { int tc_ = threadIdx.x; asm volatile("" : "+v"(tc_));
              LAS f32x4* rl = (LAS f32x4*)(F.lds + ROPE_LDS); const GAS f32x4* rg = (const GAS f32x4*)ROPE; rl[tc_] = rg[tc_]; rl[tc_ + 512] = rg[tc_ + 512];
              if (tc_ < 64) { LAS f32x4* gl = (LAS f32x4*)(F.lds + GAIN_LDS); gl[tc_] = tc_ < 32 ? ((const GAS f32x4*)(q_norm + l * 128))[tc_] : ((const GAS f32x4*)(k_norm + l * 128))[tc_ - 32]; }
              { pg8::Unit u0; S.next(0, u0);
                ((LAS f32x4*)(F.lds + RSTD_LDS))[tc_] = ((const GAS f32x4*)(RSTD + (size_t)(u0.pm & ~7) * 256))[tc_]; }
              __syncthreads(); }
            pg8::EpiProj E{QC, KC, VC, RQC, RKC, GA, RV, GR, SSQ, SSK, (LAS const float*)(F.lds + ROPE_LDS), (LAS const float*)(F.lds + GAIN_LDS), (LAS const float*)(F.lds + GAIN_LDS + 512), (LAS const float*)(F.lds + RSTD_LDS)};
            pg8::gemm_phase<pg8::EpiProj, pg8::StaticOrder, false, true>(F.lds, g, S, E);
            if (DUP(2) == 2) { __syncthreads(); pg8::gemm_phase<pg8::EpiProj, pg8::StaticOrder, false, true>(F.lds, g, S, E); }
            if (BOTH(pb + 1)) GRID_BAR();
        }
        if (PH_EN(4) && IN(pb + 2)) {
            { int tk_ = threadIdx.x; asm volatile("" : "+v"(tk_)); const int lnk = tk_ & 63; int gwk = gw; asm volatile("" : "+s"(gwk));
              for (int r4 = gwk; r4 < M * NHKV / 4; r4 += NGW) { const int hr = r4 * 4 + (lnk >> 4);
                const int s = hr & (SEQ - 1), bk = hr >> 12, kvh = bk & 3, bb = bk >> 2; const f32x4 pk = *(const f32x4*)(SSK + (((size_t)bb * SEQ + s) * 4 + kvh) * 4);
                const float rk = 1.f / sqrtf(((pk.x + pk.y) + (pk.z + pk.w)) * (1.f / 128.f) + EPS); bf16* kp = KC + (size_t)hr * 128 + (lnk & 15) * 8; *(bf16x8*)kp = scale8(ld8(kp), rk); } }
            for (int rep = 0; rep < DUP(4); ++rep)
            for (int u = F.vcu; u < BATCH * RH * 2 * 4; u += F.G) {
                const int es = u & 3, dir = (u >> 2) & 1, h = (u >> 3) & 7, b = u >> 6;
                const float lg2 = LG2T[(dir * DEPTH + l) * RH + h];
                scan_unit(b, h, dir, es, RV, RKC, FST, lg2, (char*)lds);
            }
            if (BOTH(pb + 2)) GRID_BAR();
        }
        if (PH_EN(5) && IN(pb + 3)) {
            bool nomax;
            { int ta_ = threadIdx.x; asm volatile("" : "+v"(ta_)); const int la_ = ta_ & 63;
              float gq = fmaxf(fabsf(q_norm[l * 128 + la_]), fabsf(q_norm[l * 128 + 64 + la_])), gk = fmaxf(fabsf(k_norm[l * 128 + la_]), fabsf(k_norm[l * 128 + 64 + la_]));
              gq = wave_max(gq); gk = wave_max(gk);
              const float bound = 128.f * ATT_SCALE * 1.4426950408889634f * 1.05f * gq * gk;
              nomax = __builtin_amdgcn_readfirstlane((int)(bound <= 60.f)) != 0; }
            for (int rep = 0; rep < DUP(5); ++rep)
            if (PH_EN(8)) for (int u = F.vcu; u < BATCH * NHQ * (SEQ / 256); u += F.G) {
                const int qb = u & 15, g = (u >> 4) & 3, bk = u >> 6, kvh = bk & 3, b = bk >> 2, head = kvh * 4 + g;
                const size_t r0 = (size_t)b * SEQ + (size_t)qb * 256;
                const bf16* Qb_ = QC + ((size_t)(b * NHQ + head) * SEQ + (size_t)qb * 256) * 128; const bf16* Kh_ = KC + (size_t)(b * NHKV + kvh) * SEQ * 128; const bf16* Vh_ = VC + (size_t)(b * NHKV + kvh) * SEQ * 128;
                const bf16* Gb_ = GA + ((size_t)(b * NHQ + head) * SEQ + (size_t)qb * 256) * 128; const float* sq_ = SSQ + (r0 * 16 + head) * 4; bf16* Ob_ = MIX + r0 * KP + head * 128;
#if ATT_PROBE
                attn_unit_pp<ATT_PROBE, true>(Qb_, Kh_, Vh_, Gb_, sq_, Ob_, (char*)lds, F.lds);
#endif
#if PP16
                if (nomax) attn_unit_p16(Qb_, Kh_, Vh_, Gb_, sq_, Ob_, (char*)lds, F.lds);
#else
                if (nomax) attn_unit_pp<0, true>(Qb_, Kh_, Vh_, Gb_, sq_, Ob_, (char*)lds, F.lds);
#endif
                else attn_unit_pp<0, false>(Qb_, Kh_, Vh_, Gb_, sq_, Ob_, (char*)lds, F.lds);
            }
            if (PH_EN(9)) for (int it = 0;; ++it) {
                volatile LAS unsigned* slot = F.MISC + 16 + (it & 1);
                if (threadIdx.x == 0) *slot = __hip_atomic_fetch_add((unsigned*)(F.ctl + CW_QUEUE + 64 * l), 1u, __ATOMIC_RELAXED, __HIP_MEMORY_SCOPE_AGENT);
                __syncthreads();
                const int u = (int)*slot;
                if (u >= BATCH * RH * NCH) break;
                const int j = u & 31, h = (u >> 5) & 7, b = u >> 8;
                const float lgf2 = LG2T[l * RH + h], lgb2 = LG2T[(DEPTH + l) * RH + h];
                ret_out_unit(b, h, j, RV, GR, RQC, RKC, FST, MIX, ret_norm + ((size_t)l * RH + h) * 256, lgf2, lgb2, (char*)lds);
            }
            if (BOTH(pb + 3)) GRID_BAR();
        }
        if (PH_EN(6) && IN(pb + 4)) {
            pg8::Gemm g{MIX, WOUT + (size_t)l * DM * KP, M, DM, DM, KP}; pg8::StaticOrder S; S.init(M, DM, F.G, (int)blockIdx.x);
            pg8::EpiResBf16 E{XCUR, DM, SSX};
            pg8::gemm_phase<pg8::EpiResBf16, pg8::StaticOrder, false, true>(F.lds, g, S, E);
            if (DUP(7) == 2 && l == 0) { __syncthreads(); pg8::gemm_phase<pg8::EpiResBf16, pg8::StaticOrder, true, true>(F.lds, g, S, E); }
            if (BOTH(pb + 4)) GRID_BAR();
        }
    }
    if (PH_EN(7) && IN(NPH - 1)) {
        const bool poison = !MK_PER_PHASE && (xb_ld(&bar.bar[XB_TMO]) != 0u);
        int tf_ = threadIdx.x; asm volatile("" : "+v"(tf_)); const int lnf = tf_ & 63;
        int gwf = gw; asm volatile("" : "+s"(gwf));
        for (int m = gwf; m < M; m += NGW) rms_row_bf16_to_f32(XCUR + (size_t)m * DM, final_norm, args.out + (size_t)m * DM, lnf, poison);
    }
#undef IN
#undef BOTH
#undef GRID_BAR
}

extern "C" void kernel_launch(void* const* d_in, const int* in_sizes, int n_in, void* d_out, int out_size, void* d_ws, size_t ws_size, hipStream_t stream) {
    static int grid = 0;
    if (grid == 0) {
        if (n_in != 10 || in_sizes[0] != M * DM || out_size != M * DM || ws_size < WS_END) {
            fprintf(stderr, "kernel_launch: shape/workspace mismatch: n_in %d in0 %d out %d ws %zu (need %zu); nothing launched\n", n_in, n_in > 0 ? in_sizes[0] : -1, out_size, ws_size, (size_t)WS_END); grid = -1; return; }
        int dev = 0, cus = 0, per_cu = 0;
        if (hipGetDevice(&dev) != hipSuccess || hipDeviceGetAttribute(&cus, hipDeviceAttributeMultiprocessorCount, dev) != hipSuccess) { fprintf(stderr, "kernel_launch: device query failed\n"); grid = -1; return; }
        if (hipFuncSetAttribute((const void*)hymba_fwd, hipFuncAttributeMaxDynamicSharedMemorySize, LDS_BYTES) != hipSuccess) { fprintf(stderr, "kernel_launch: hipFuncSetAttribute failed\n"); grid = -1; return; }
        if (hipOccupancyMaxActiveBlocksPerMultiprocessor(&per_cu, (const void*)hymba_fwd, NWAVES * 64, LDS_BYTES) != hipSuccess || per_cu < 1)
            fprintf(stderr, "kernel_launch: note: occupancy query reports %d workgroups per CU\n", per_cu);
        (void)hipGetLastError();
        grid = cus >= 8 ? (cus & ~7) : cus;
        if (grid % 8 != 0) { fprintf(stderr, "kernel_launch: needs at least 8 CUs\n"); grid = -1; return; }
    }
    if (grid < 0) return;
    if (hipMemsetAsync((char*)d_ws + WS_CTL, 0, CTL_ZERO_BYTES, stream) != hipSuccess) { fprintf(stderr, "kernel_launch: memset failed\n"); return; }
    Args a{};
    for (int i = 0; i < 10; ++i) a.in[i] = (const float*)d_in[i];
    a.out = (float*)d_out; a.ws = (unsigned char*)d_ws;
#if MK_PER_PHASE
    for (int p = 0; p < NPH; ++p) { a.ph_lo = p; a.ph_hi = p + 1; hipLaunchKernelGGL(hymba_fwd, dim3(grid), dim3(NWAVES * 64), LDS_BYTES, stream, a); }
#else
    a.ph_lo = 0; a.ph_hi = NPH; hipLaunchKernelGGL(hymba_fwd, dim3(grid), dim3(NWAVES * 64), LDS_BYTES, stream, a);
#endif
    const hipError_t le = hipPeekAtLastError();
    if (le != hipSuccess) fprintf(stderr, "kernel_launch: launch failed: %s\n", hipGetErrorName(le));
}
```
